# Optimizing an MI355X kernel written in HIP

```python
import jax
import jax.numpy as jnp
from jax import lax
import numpy as np

D_MODEL = 1024
BATCH = 4
SEQ = 4096
DEPTH = 2

MEM_LEN = 256
W_A = D_MODEL
A_CONV = 3
W_B = D_MODEL
B_CONV = 31
X_HEADS = 4
X_HEAD_DIM = D_MODEL // X_HEADS
W_X = X_HEADS * X_HEAD_DIM
N_BRANCH = 3
N_IN = 3 * W_A + 2 * W_B + W_X + N_BRANCH * D_MODEL
SPLITS = [W_A, 2 * W_A, 3 * W_A, 3 * W_A + 2 * W_B, 3 * W_A + 2 * W_B + W_X]
N_GROUPS = 4
EXPERTS_PER_GROUP = 8
N_EXPERTS = N_GROUPS * EXPERTS_PER_GROUP
TOP_K_IN_GROUP = 2
D_FF_EXPERT = D_MODEL // 2
EPS = 1e-6

kernel_name = "hybrid_gated_conv_xattn_hmoe"


def rms_norm(x, g):
    xf = x.astype(jnp.float32)
    y = xf * lax.rsqrt(jnp.mean(xf * xf, axis=-1, keepdims=True) + EPS)
    return (y * g.astype(jnp.float32)).astype(x.dtype)


def layer_norm(x, g, b):
    xf = x.astype(jnp.float32)
    mu = jnp.mean(xf, axis=-1, keepdims=True)
    xc = xf - mu
    var = jnp.mean(xc * xc, axis=-1, keepdims=True)
    y = xc * lax.rsqrt(var + EPS) * g.astype(jnp.float32) + b.astype(jnp.float32)
    return y.astype(x.dtype)


def causal_depthwise_conv(u, w):
    k, c = w.shape
    return lax.conv_general_dilated(
        u, w[:, None, :].astype(u.dtype), window_strides=(1,), padding=[(k - 1, 0)],
        dimension_numbers=("NWC", "WIO", "NWC"), feature_group_count=c)


def setup_inputs(seed: int = 0) -> dict:
    key = jax.random.key(seed)
    ks = jax.random.split(key, 26)
    f32 = jnp.float32
    nrm = lambda k, shape, scale: jax.random.normal(k, shape, f32) * scale
    L, D = DEPTH, D_MODEL
    return {
        "x": nrm(ks[0], (BATCH, SEQ, D), 1.0),
        "mem": nrm(ks[1], (BATCH, MEM_LEN, D), 1.0),
        "mix_norm_g": 1.0 + nrm(ks[2], (L, D), 0.02),
        "mem_norm_g": 1.0 + nrm(ks[3], (L, D), 0.02),
        "w_in": nrm(ks[4], (L, D, N_IN), D ** -0.5),
        "b_gate": nrm(ks[5], (L, N_BRANCH * D), 0.02),
        "conv_a_w": nrm(ks[6], (L, A_CONV, W_A), A_CONV ** -0.5),
        "w_out_a": nrm(ks[7], (L, W_A, D), W_A ** -0.5),
        "b_glu": nrm(ks[8], (L, 2 * W_B), 0.02),
        "conv_b_w": nrm(ks[9], (L, B_CONV, W_B), B_CONV ** -0.5),
        "conv_b_b": nrm(ks[10], (L, W_B), 0.02),
        "ln_b_g": 1.0 + nrm(ks[11], (L, W_B), 0.02),
        "ln_b_b": nrm(ks[12], (L, W_B), 0.02),
        "w_out_b": nrm(ks[13], (L, W_B, D), W_B ** -0.5),
        "b_out_b": nrm(ks[14], (L, D), 0.02),
        "w_kv": nrm(ks[15], (L, D, 2 * W_X), D ** -0.5),
        "w_out_x": nrm(ks[16], (L, W_X, D), W_X ** -0.5),
        "w_o": nrm(ks[17], (L, D, D), D ** -0.5),
        "ffn_norm_g": 1.0 + nrm(ks[18], (L, D), 0.02),
        "w_group": nrm(ks[19], (L, D, N_GROUPS), D ** -0.5),
        "b_group": nrm(ks[20], (L, N_GROUPS), 0.01),
        "w_router": nrm(ks[21], (L, D, N_EXPERTS), D ** -0.5),
        "b_router": nrm(ks[22], (L, N_EXPERTS), 0.01),
        "w_gate_up": nrm(ks[23], (L, N_EXPERTS, D, 2 * D_FF_EXPERT), D ** -0.5),
        "w_down": nrm(ks[24], (L, N_EXPERTS, D_FF_EXPERT, D), D_FF_EXPERT ** -0.5),
        "final_norm_g": 1.0 + nrm(ks[25], (D,), 0.02),
    }


def cross_attention(q, mem_n, w_kv):
    b, s, _ = q.shape
    kv = mem_n @ w_kv
    k, v = jnp.split(kv, 2, axis=-1)
    qh = q.reshape(b, s, X_HEADS, X_HEAD_DIM)
    kh = k.reshape(b, -1, X_HEADS, X_HEAD_DIM)
    vh = v.reshape(b, -1, X_HEADS, X_HEAD_DIM)
    scores = jnp.einsum("bshd,bmhd->bhsm", qh, kh).astype(jnp.float32) * (X_HEAD_DIM ** -0.5)
    probs = jax.nn.softmax(scores, axis=-1).astype(vh.dtype)
    out = jnp.einsum("bhsm,bmhd->bshd", probs, vh)
    return out.reshape(b, s, W_X)


def hierarchical_moe(z, w_group, b_group, w_router, b_router, w_gate_up, w_down):
    g_logits = (z @ w_group).astype(jnp.float32) + b_group.astype(jnp.float32)
    g_probs = jax.nn.softmax(g_logits, axis=-1)
    g_sel = jnp.argmax(g_probs, axis=-1)
    g_p = jnp.max(g_probs, axis=-1)
    e_logits = (z @ w_router).astype(jnp.float32) + b_router.astype(jnp.float32)
    e_logits = e_logits.reshape(z.shape[0], z.shape[1], N_GROUPS, EXPERTS_PER_GROUP)
    e_in_group = jnp.take_along_axis(e_logits, g_sel[..., None, None], axis=2)[..., 0, :]
    e_probs = jax.nn.softmax(e_in_group, axis=-1)
    top_p, top_i = lax.top_k(e_probs, TOP_K_IN_GROUP)
    top_w = top_p / jnp.sum(top_p, axis=-1, keepdims=True)
    global_idx = g_sel[..., None] * EXPERTS_PER_GROUP + top_i
    combine = jnp.sum(jax.nn.one_hot(global_idx, N_EXPERTS, dtype=jnp.float32) * top_w[..., None], axis=-2)
    combine = (combine * g_p[..., None]).astype(z.dtype)
    y = jnp.zeros_like(z)
    for e in range(N_EXPERTS):
        gate, up = jnp.split(z @ w_gate_up[e], 2, axis=-1)
        y = y + combine[..., e:e + 1] * ((jax.nn.silu(gate) * up) @ w_down[e])
    return y


def reference(x, mem, mix_norm_g, mem_norm_g, w_in, b_gate, conv_a_w, w_out_a, b_glu,
              conv_b_w, conv_b_b, ln_b_g, ln_b_b, w_out_b, b_out_b, w_kv, w_out_x, w_o,
              ffn_norm_g, w_group, b_group, w_router, b_router, w_gate_up, w_down,
              final_norm_g):
    b, s, d = x.shape
    for l in range(DEPTH):
        x_n = rms_norm(x, mix_norm_g[l])
        h = x_n @ w_in[l]
        a_val, a_gb, a_gc, h_glu, q, h_gate = jnp.split(h, SPLITS, axis=-1)

        y_a = (a_gb * causal_depthwise_conv(a_gc * a_val, conv_a_w[l])) @ w_out_a[l]

        glu_val, glu_gate = jnp.split(h_glu + b_glu[l], 2, axis=-1)
        u = glu_val * jax.nn.sigmoid(glu_gate)
        u = causal_depthwise_conv(u, conv_b_w[l]) + conv_b_b[l]
        u = jax.nn.silu(layer_norm(u, ln_b_g[l], ln_b_b[l]))
        y_b = u @ w_out_b[l] + b_out_b[l]

        mem_n = rms_norm(mem, mem_norm_g[l])
        y_x = cross_attention(q, mem_n, w_kv[l]) @ w_out_x[l]

        gates = jax.nn.sigmoid(h_gate + b_gate[l]).reshape(b, s, N_BRANCH, d)
        merged = gates[..., 0, :] * y_a + gates[..., 1, :] * y_b + gates[..., 2, :] * y_x
        x = x + merged @ w_o[l]

        z = rms_norm(x, ffn_norm_g[l])
        x = x + hierarchical_moe(z, w_group[l], b_group[l], w_router[l], b_router[l],
                                 w_gate_up[l], w_down[l])
    return rms_norm(x, final_norm_g)
```

```cpp
#include <hip/hip_runtime.h>
#include <cstdio>
#include <cstdint>
typedef unsigned short bf16_t;
__device__ __forceinline__ float bf2f(bf16_t b) { return __uint_as_float(((unsigned)b) << 16); }
__device__ __forceinline__ bf16_t f2bf(float f) { unsigned u = __float_as_uint(f); return (bf16_t)((u + 0x7fffu + ((u >> 16) & 1u)) >> 16); }

constexpr int T_ROWS = 16384, DM = 1024, SEQ = 4096, NB = 4, MEMLEN = 256, NLAYER = 2, NIN = 9216, NEXP = 32, DFF = 512;
constexpr int SLOTS_MAX = 40960;
constexpr size_t MiB = (size_t)1 << 20;
constexpr size_t WS_CTL = 0, CTL_BYTES = 1 * MiB;
constexpr size_t WS_W = 1 * MiB;
constexpr size_t W_IN = 1 * MiB, W_OA = 37 * MiB, W_OB = 41 * MiB, W_OX = 45 * MiB, W_O = 49 * MiB, W_KV = 53 * MiB, W_GU = 61 * MiB, W_DN = 189 * MiB, W_RT = 253 * MiB;
#define GAS __attribute__((address_space(1)))
constexpr size_t WS_XB = 272 * MiB, WS_CV = 304 * MiB, WS_GB = 336 * MiB, WS_U = 368 * MiB, WS_Q = 400 * MiB, WS_G = 432 * MiB;
constexpr size_t WS_AC = 528 * MiB, WS_UB = 560 * MiB, WS_O = 592 * MiB, WS_MG = 624 * MiB;
constexpr size_t WS_KV = 656 * MiB, WS_MEMN = 664 * MiB, WS_RT = 668 * MiB;
constexpr size_t RT_RS = 0, RT_TOKE = 64 * 1024, RT_TOKP = 192 * 1024, RT_TOKW = 320 * 1024, RT_BASE = 448 * 1024, RT_LIST = 1 * MiB;
constexpr size_t WS_XR = 920 * MiB;
constexpr size_t WS_HID = 672 * MiB, WS_Y = 712 * MiB, WS_F32A = 792 * MiB, WS_RSL = 984 * MiB, WS_END = 986 * MiB;
constexpr int CW_TMO = 16, CW_TCNT = 131072, TCNT_LAYER = 16384;
constexpr int CW_PCNT = 163840, PCNT_LAYER = 8192;
constexpr int CW_CNT = 1024, CNT_STRIDE = 64, CNT_LAYER = 2048;

namespace ge {
#define LAS __attribute__((address_space(3)))
typedef short bf16x8 __attribute__((ext_vector_type(8)));
typedef float f32x4 __attribute__((ext_vector_type(4)));
typedef unsigned u32x4 __attribute__((ext_vector_type(4)));
constexpr int BM = 256, BK = 64, HALF = 128, HTB = HALF * BK * 2, STAGE_BYTES = 8 * HTB, NXCD = 8, WGM = 8;

__host__ __device__ __forceinline__ int lds_byte(int r, int c) { const int st = (r >> 4) * 2 + (c >> 5), rr = r & 15, cc = c & 31, ob = rr * 64 + cc * 2; return st * 1024 + (ob ^ (((ob >> 9) & 1) << 5)); }
__host__ __device__ __forceinline__ void stage_rc(int b, int& R, int& C) { const int st = b / 1024, sb = b % 1024, swz = sb ^ (((sb >> 9) & 1) << 5); R = (st >> 1) * 16 + swz / 64; C = (st & 1) * 32 + (swz % 64) / 2; }
__host__ __device__ __forceinline__ int perm32(int rho) { const int n = rho >> 4, i = rho & 15; return 8 * (i >> 2) + 4 * n + (i & 3); }

typedef float f32x2_cv __attribute__((ext_vector_type(2)));
typedef __bf16 bf16x2_cv __attribute__((ext_vector_type(2)));
__device__ __forceinline__ unsigned cvt_pk_bf16(float lo, float hi) { const f32x2_cv v = {lo, hi}; const bf16x2_cv b = __builtin_convertvector(v, bf16x2_cv); return __builtin_bit_cast(unsigned, b); }
__device__ __forceinline__ u32x4 pack8(const f32x4 a, const f32x4 b) { u32x4 w; w.x = cvt_pk_bf16(a[0], a[1]); w.y = cvt_pk_bf16(a[2], a[3]); w.z = cvt_pk_bf16(b[0], b[1]); w.w = cvt_pk_bf16(b[2], b[3]); return w; }
__device__ __forceinline__ float fsigm(float x) { return __builtin_amdgcn_rcpf(1.0f + __builtin_amdgcn_exp2f(-1.44269504f * x)); }
__device__ __forceinline__ f32x4 sigm4(const f32x4 x) { f32x4 r; r[0] = fsigm(x[0]); r[1] = fsigm(x[1]); r[2] = fsigm(x[2]); r[3] = fsigm(x[3]); return r; }
__device__ __forceinline__ void unpack8(const u32x4 w, f32x4& a, f32x4& b) {
    a[0] = __uint_as_float(w.x << 16); a[1] = __uint_as_float(w.x & 0xffff0000u); a[2] = __uint_as_float(w.y << 16); a[3] = __uint_as_float(w.y & 0xffff0000u);
    b[0] = __uint_as_float(w.z << 16); b[1] = __uint_as_float(w.z & 0xffff0000u); b[2] = __uint_as_float(w.w << 16); b[3] = __uint_as_float(w.w & 0xffff0000u); }

__device__ __forceinline__ void st16_wt(void* ubase, unsigned loff, const u32x4 v) { asm volatile("s_nop 4\n\tglobal_store_dwordx4 %0, %1, %2 sc1\n\ts_nop 1" :: "v"(loff), "v"(v), "s"(ubase) : "memory"); }
__device__ __forceinline__ void st16_wt(void* ubase, unsigned loff, const f32x4 v) { asm volatile("s_nop 4\n\tglobal_store_dwordx4 %0, %1, %2 sc1\n\ts_nop 1" :: "v"(loff), "v"(v), "s"(ubase) : "memory"); }
__device__ __forceinline__ void st16_buf(void* ubase, unsigned loff, const u32x4 v) {
    const __amdgpu_buffer_rsrc_t r = __builtin_amdgcn_make_buffer_rsrc(ubase, 0, 0x7fffffff, 0x00020000);
    __builtin_amdgcn_raw_buffer_store_b128(v, r, loff, 0, 16); }
__device__ __forceinline__ int xcd_remap(int L, int nwg) { const int q = nwg / NXCD, r = nwg % NXCD, xcd = L % NXCD, off = L / NXCD; return (xcd < r ? xcd * (q + 1) : r * (q + 1) + (xcd - r) * q) + off; }
__device__ __forceinline__ void tile_order(int L, int nM, int nN, int& pm, int& pn) {
    const int wgid = xcd_remap(L, nM * nN);
    const int nig = WGM * nN, gid = wgid / nig, fm = gid * WGM, gsz = (nM - fm) < WGM ? (nM - fm) : WGM;
    pm = fm + ((wgid % nig) % gsz); pn = (wgid % nig) / gsz;
}

struct Unit { int pm, pn, sub, aux; };

template <class P>
__device__ __forceinline__ void gemm_phase(LAS unsigned char* lds, const P& ph) {
    int tid = threadIdx.x; asm volatile("" : "+v"(tid));
    const int wid = __builtin_amdgcn_readfirstlane(tid >> 6), lane = tid & 63, wr = wid >> 2, wc = wid & 3, fr = lane & 15, fq = lane >> 4;
    constexpr int nt = P::NT;
    unsigned voffA[2], voffB[2];
#pragma unroll
    for (int i = 0; i < 2; ++i) { int R, C; stage_rc(tid * 16 + i * 8192, R, C); const int Rb = (R & ~31) + perm32(R & 31); voffA[i] = (unsigned)(R * P::LDA + C) * 2u; voffB[i] = (unsigned)(Rb * P::KB + C) * 2u; }
    constexpr size_t hstepA = P::GATHER ? 0 : (size_t)HALF * P::LDA * 2;
    const size_t kstep = (size_t)(BK * 2);
    const unsigned ldsw = (unsigned)wid * 1024u;
    const int aoff = lds_byte(wr * 64 + fr, fq * 8), boff = lds_byte(wc * 32 + fr, fq * 8);
#define GE_SA(b, h) (((b) * 2 + (h)) * HTB)
#define GE_SB(b, h) ((4 + (b) * 2 + (h)) * HTB)
#define GE_STAGE(bufoff, gbase, voff) do { _Pragma("unroll") for (int _i = 0; _i < 2; ++_i) \
        __builtin_amdgcn_global_load_lds((const unsigned*)((const char*)(gbase) + (voff)[_i]), (LAS unsigned*)(lds + (bufoff) + ldsw + _i * 8192), 16, 0, 0); } while (0)
#define GE_LDA(dst, b, h) do { _Pragma("unroll") for (int m = 0; m < 4; ++m) _Pragma("unroll") for (int k = 0; k < 2; ++k) dst[m][k] = *(const LAS bf16x8*)(lds + GE_SA(b, h) + aoff + m * 2048 + k * 1024); } while (0)
#define GE_LDB(dst, b, h) do { _Pragma("unroll") for (int n = 0; n < 2; ++n) _Pragma("unroll") for (int k = 0; k < 2; ++k) dst[n][k] = *(const LAS bf16x8*)(lds + GE_SB(b, h) + boff + n * 2048 + k * 1024); } while (0)
#define GE_MMA(ai, bj, At, Bt) do { __builtin_amdgcn_s_setprio(1); _Pragma("unroll") for (int m = 0; m < 4; ++m) _Pragma("unroll") for (int n = 0; n < 2; ++n) _Pragma("unroll") for (int k = 0; k < 2; ++k) \
        acc[ai][bj][m][n] = __builtin_amdgcn_mfma_f32_16x16x32_bf16(Bt[n][k], At[m][k], acc[ai][bj][m][n], 0, 0, 0); __builtin_amdgcn_s_setprio(0); } while (0)
#define GE_WAIT_V(n) asm volatile("s_waitcnt vmcnt(" #n ")" ::: "memory")
#define GE_WAIT_L(n) asm volatile("s_waitcnt lgkmcnt(" #n ")" ::: "memory")
#define GE_BAR __builtin_amdgcn_s_barrier()
#define GE_SCHED __builtin_amdgcn_sched_barrier(0)
    Unit cur, nxt; int ui = 0;
    if (!ph.next(0, cur)) return;
    f32x4 acc[2][2][4][2];
#pragma unroll
    for (int a = 0; a < 2; ++a)
#pragma unroll
        for (int b = 0; b < 2; ++b)
#pragma unroll
            for (int m = 0; m < 4; ++m)
#pragma unroll
                for (int n = 0; n < 2; ++n) acc[a][b][m][n] = (f32x4){0.f, 0.f, 0.f, 0.f};
    bf16x8 At[4][2], B0[2][2], B1[2][2];
    unsigned cao[2][2], nao[2][2];
    if constexpr (P::GATHER) ph.a_offs(cur, tid, cao);
#define GE_STAGE_A(bufoff, gbase, h, offs) do { if constexpr (P::GATHER) { GE_STAGE(bufoff, gbase, (offs)[h]); } else { GE_STAGE(bufoff, (gbase) + (h) * hstepA, voffA); } } while (0)
    const char* cA = ph.a_base(cur); const char* cB0 = ph.b_base(cur, 0); const char* cB1 = ph.b_base(cur, 1);
    ph.a_ready(cur);
    GE_STAGE(GE_SB(0, 0), cB0, voffB); GE_STAGE(GE_SB(0, 1), cB1, voffB); GE_STAGE_A(GE_SA(0, 0), cA, 0, cao); GE_STAGE_A(GE_SA(0, 1), cA, 1, cao);
    if (wr == 1) GE_BAR;
    GE_WAIT_V(2); GE_BAR;
    GE_STAGE(GE_SB(1, 0), cB0 + kstep, voffB); GE_STAGE_A(GE_SA(1, 0), cA + kstep, 0, cao); GE_STAGE(GE_SB(1, 1), cB1 + kstep, voffB);
    GE_WAIT_V(6); GE_BAR;
    for (;;) {
        const bool has_next = ph.next(ui + 1, nxt);
        const char* nA = cA; const char* nB0 = cB0; const char* nB1 = cB1;
        if constexpr (P::GATHER) {
#pragma unroll
            for (int h = 0; h < 2; ++h)
#pragma unroll
                for (int i = 0; i < 2; ++i) nao[h][i] = cao[h][i]; }
        if (has_next) { nA = ph.a_base(nxt); nB0 = ph.b_base(nxt, 0); nB1 = ph.b_base(nxt, 1); if constexpr (P::GATHER) ph.a_offs(nxt, tid, nao); }
        for (int t = 0; t < nt; t += 2) {
            const bool last = (t == nt - 2);
            if (last && has_next) ph.a_ready(nxt);
            const char* a1 = cA + (size_t)(t + 1) * kstep;
            const char* a2 = last ? nA : cA + (size_t)(t + 2) * kstep;
            const char* b20 = last ? nB0 : cB0 + (size_t)(t + 2) * kstep; const char* b21 = last ? nB1 : cB1 + (size_t)(t + 2) * kstep;
            const char* a3 = a2 + kstep; const char* b30 = b20 + kstep; const char* b31 = b21 + kstep;
            unsigned ao2[2][2];
            if constexpr (P::GATHER) {
#pragma unroll
                for (int h = 0; h < 2; ++h)
#pragma unroll
                    for (int i = 0; i < 2; ++i) ao2[h][i] = last ? nao[h][i] : cao[h][i]; }
            GE_LDB(B0, 0, 0); GE_LDB(B1, 0, 1); GE_SCHED; GE_LDA(At, 0, 0); GE_STAGE_A(GE_SA(1, 1), a1, 1, cao);
            GE_WAIT_V(8); GE_WAIT_L(0); GE_BAR; GE_MMA(0, 0, At, B0); GE_MMA(0, 1, At, B1); GE_BAR; GE_SCHED;
            GE_LDA(At, 0, 1); GE_STAGE(GE_SB(0, 0), b20, voffB); GE_STAGE(GE_SB(0, 1), b21, voffB); GE_STAGE_A(GE_SA(0, 0), a2, 0, ao2);
            GE_WAIT_V(8); GE_WAIT_L(0); GE_BAR; GE_MMA(1, 0, At, B0); GE_MMA(1, 1, At, B1); GE_BAR; GE_SCHED;
            GE_LDB(B0, 1, 0); GE_LDB(B1, 1, 1); GE_SCHED; GE_LDA(At, 1, 0); GE_STAGE_A(GE_SA(0, 1), a2, 1, ao2);
            GE_WAIT_V(8); GE_WAIT_L(0); GE_BAR; GE_MMA(0, 0, At, B0); GE_MMA(0, 1, At, B1); GE_BAR; GE_SCHED;
            GE_LDA(At, 1, 1); GE_STAGE(GE_SB(1, 0), b30, voffB); GE_STAGE(GE_SB(1, 1), b31, voffB); GE_STAGE_A(GE_SA(1, 0), a3, 0, ao2);
            GE_WAIT_V(8); GE_WAIT_L(0); GE_BAR; GE_MMA(1, 0, At, B0); GE_MMA(1, 1, At, B1); GE_BAR; GE_SCHED;
        }
        if (wr == 0) GE_BAR;
        ph.epilogue(acc, cur, wr, wc, fr, fq);
#ifdef EPI_TWICE
        if constexpr (P::NT == 16 && P::KB == 1024 && !P::GATHER && sizeof(P) > 90) ph.epilogue(acc, cur, wr, wc, fr, fq);
#endif
        ph.done(cur);
        if (!has_next) break;
        if (!ph.keep_acc(cur)) {
#pragma unroll
            for (int a = 0; a < 2; ++a)
#pragma unroll
                for (int b = 0; b < 2; ++b)
#pragma unroll
                    for (int m = 0; m < 4; ++m)
#pragma unroll
                        for (int n = 0; n < 2; ++n) acc[a][b][m][n] = (f32x4){0.f, 0.f, 0.f, 0.f};
        }
        cur = nxt; cA = nA; cB0 = nB0; cB1 = nB1; ++ui;
        if constexpr (P::GATHER) {
#pragma unroll
            for (int h = 0; h < 2; ++h)
#pragma unroll
                for (int i = 0; i < 2; ++i) cao[h][i] = nao[h][i]; }
        if (wr == 1) GE_BAR;
    }
    GE_WAIT_V(0);
    GE_BAR;
#undef GE_SA
#undef GE_SB
#undef GE_STAGE
#undef GE_STAGE_A
#undef GE_LDA
#undef GE_LDB
#undef GE_MMA
#undef GE_WAIT_V
#undef GE_WAIT_L
#undef GE_BAR
#undef GE_SCHED
}
}
namespace gp {
using namespace ge;
typedef const char* cptr;
#define GP_ROW(ai, m) (128 * (ai) + 64 * wr + 16 * (m) + fr)
#define GP_COL(bj) (128 * (bj) + 32 * wc + 8 * fq)
__device__ __forceinline__ void ld8f(const float* p, f32x4& a, f32x4& b) { a = *(const f32x4*)p; b = *(const f32x4*)(p + 4); }
__device__ __forceinline__ void st8b(bf16_t* p, const f32x4 a, const f32x4 b) { *(u32x4*)p = pack8(a, b); }

#define GP_LD16(ubase, loff) (*(const u32x4*)((const char*)(ubase) + (loff)))
#ifdef BUF_STORES
#define GP_ST16(ubase, loff, val) st16_buf((void*)(ubase), (loff), (val))
#elif !defined(WT_STORES)
#define GP_ST16(ubase, loff, val) (*(u32x4*)((char*)(ubase) + (loff)) = (val))
#else
#define GP_ST16(ubase, loff, val) st16_wt((void*)(ubase), (loff), (val))
#endif
#define GP_FENCE() asm volatile("" ::: "memory")

constexpr unsigned HOOK_SPIN_CAP = 1u << 20;
__device__ __forceinline__ void hook_publish(unsigned* cnt) {
    asm volatile("s_waitcnt vmcnt(0)" ::: "memory");
    if ((threadIdx.x & 63) == 0) __hip_atomic_fetch_add(cnt, 1u, __ATOMIC_RELAXED, __HIP_MEMORY_SCOPE_AGENT);
}
__device__ __forceinline__ void hook_wait(unsigned* cnt, unsigned need, unsigned* tmo) {
    if (threadIdx.x < 64) {
        unsigned spins = 0;
        while ((unsigned)__builtin_amdgcn_readfirstlane(__hip_atomic_load(cnt, __ATOMIC_RELAXED, __HIP_MEMORY_SCOPE_AGENT)) < need) {
            if ((++spins & 255u) == 0u && (__builtin_amdgcn_readfirstlane(__hip_atomic_load(tmo, __ATOMIC_RELAXED, __HIP_MEMORY_SCOPE_AGENT)) != 0u || spins > HOOK_SPIN_CAP)) { if (threadIdx.x == 0) __hip_atomic_store(tmo, 1u, __ATOMIC_RELAXED, __HIP_MEMORY_SCOPE_AGENT); break; }
            __builtin_amdgcn_s_sleep(2); }
        __builtin_amdgcn_fence(__ATOMIC_ACQUIRE, "agent");
        asm volatile("s_waitcnt vmcnt(0)" ::: "memory");
    }
    asm volatile("" ::: "memory"); __builtin_amdgcn_s_barrier(); asm volatile("" ::: "memory");
}
struct PhGemm1 {
    static constexpr int NT = 16, KB = 1024, LDA = 1024; static constexpr bool GATHER = false;
    cptr XB, WT; const float *rs, *bglu, *bgate; bf16_t *CV, *GB, *U, *Q, *G; int Gd, c, only, nconv, ucv;
    __device__ __forceinline__ bool next(int i, Unit& u) const { if (only > 0) { if (i > 0) return false; i = only - 1; }
        int L;
        if (nconv > 0) { const int ng = Gd - nconv, ncu = ucv * nconv, ngu = 64 * 36 - ncu;
            if (c < ng) { L = i * ng + c; if (L >= ngu) return false; } else { if (i >= ucv) return false; L = ngu + i * nconv + (c - ng); } }
        else L = i * Gd + c;
        if (L >= 64 * 36) return false; tile_order(L, 64, 36, u.pm, u.pn); u.sub = 0; u.aux = 0; return true; }
    __device__ __forceinline__ cptr a_base(const Unit& u) const { return XB + (size_t)u.pm * 256 * 2048; }
    __device__ __forceinline__ cptr b_base(const Unit& u, int half) const {
        const int pn = u.pn; int row;
        if (pn < 8) row = half ? 2048 + 128 * pn : 128 * pn;
        else if (pn < 12) row = 1024 + 256 * (pn - 8) + 128 * half;
        else if (pn < 20) row = (half ? 4096 : 3072) + 128 * (pn - 12);
        else if (pn < 24) row = 5120 + 256 * (pn - 20) + 128 * half;
        else row = 6144 + 256 * (pn - 24) + 128 * half;
        return WT + (size_t)row * 2048;
    }
    __device__ __forceinline__ bool keep_acc(const Unit&) const { return false; }
    __device__ __forceinline__ void a_ready(const Unit&) const {}
    __device__ __forceinline__ void done(const Unit&) const {}
    __device__ __forceinline__ void epilogue(f32x4 (&acc)[2][2][4][2], const Unit& u, int wr, int wc, int fr, int fq) const {
        const int pn = u.pn; const size_t row0 = (size_t)u.pm * 256 + 64 * wr;
        const unsigned lo = (unsigned)(fr * 1024 + 32 * wc + 8 * fq) * 2u;
        if (pn < 8) {
            bf16_t* ob = CV + row0 * 1024 + 128 * pn;
#pragma unroll
            for (int ai = 0; ai < 2; ++ai)
#pragma unroll
                for (int m = 0; m < 4; ++m) {
                    GP_ST16(ob + (size_t)(128 * ai + 16 * m) * 1024, lo, pack8(acc[ai][0][m][0] * acc[ai][1][m][0], acc[ai][0][m][1] * acc[ai][1][m][1])); GP_FENCE(); }
        } else if (pn < 12 || (pn >= 20 && pn < 24)) {
            bf16_t* ob = (pn < 12 ? GB + 256 * (pn - 8) : Q + 256 * (pn - 20)) + row0 * 1024;
#pragma unroll
            for (int ai = 0; ai < 2; ++ai)
#pragma unroll
                for (int m = 0; m < 4; ++m) {
#pragma unroll
                    for (int bj = 0; bj < 2; ++bj) GP_ST16(ob + (size_t)(128 * ai + 16 * m) * 1024 + 128 * bj, lo, pack8(acc[ai][bj][m][0], acc[ai][bj][m][1]));
                    GP_FENCE(); }
        } else if (pn < 20) {
            const int c0 = 128 * (pn - 12); bf16_t* ob = U + row0 * 1024 + c0; const unsigned bo = (unsigned)(32 * wc + 8 * fq) * 4u;
            const f32x4 bv0 = *(const f32x4*)((const char*)(bglu + c0) + bo), bv1 = *(const f32x4*)((const char*)(bglu + c0 + 4) + bo);
            const f32x4 bg0 = *(const f32x4*)((const char*)(bglu + 1024 + c0) + bo), bg1 = *(const f32x4*)((const char*)(bglu + 1028 + c0) + bo);
#pragma unroll
            for (int ai = 0; ai < 2; ++ai)
#pragma unroll
                for (int m = 0; m < 4; ++m) {
                    GP_ST16(ob + (size_t)(128 * ai + 16 * m) * 1024, lo, pack8((acc[ai][0][m][0] + bv0) * sigm4(acc[ai][1][m][0] + bg0), (acc[ai][0][m][1] + bv1) * sigm4(acc[ai][1][m][1] + bg1))); GP_FENCE(); }
        } else {
            const int j = pn - 24, gi = j >> 2, c0 = 256 * (j & 3); bf16_t* ob = G + (size_t)gi * T_ROWS * 1024 + row0 * 1024 + c0; const float* bp = bgate + gi * 1024 + c0; const unsigned bo = (unsigned)(32 * wc + 8 * fq) * 4u;
            const f32x4 b00 = *(const f32x4*)((const char*)bp + bo), b01 = *(const f32x4*)((const char*)(bp + 4) + bo), b10 = *(const f32x4*)((const char*)(bp + 128) + bo), b11 = *(const f32x4*)((const char*)(bp + 132) + bo);
#pragma unroll
            for (int ai = 0; ai < 2; ++ai)
#pragma unroll
                for (int m = 0; m < 4; ++m) {
                    GP_ST16(ob + (size_t)(128 * ai + 16 * m) * 1024, lo, pack8(sigm4(acc[ai][0][m][0] + b00), sigm4(acc[ai][0][m][1] + b01)));
                    GP_ST16(ob + (size_t)(128 * ai + 16 * m) * 1024 + 128, lo, pack8(sigm4(acc[ai][1][m][0] + b10), sigm4(acc[ai][1][m][1] + b11))); GP_FENCE(); }
        }
    }
};

struct PhKV {
    static constexpr int NT = 16, KB = 1024, LDA = 1024; static constexpr bool GATHER = false;
    cptr MEMN, WT; bf16_t* KV; int Gd, c, nconv;
    __device__ __forceinline__ bool next(int i, Unit& u) const { int L = i * Gd + c; (void)nconv; if (L >= 64) return false; u.sub = L >> 5; u.pm = (L & 31) >> 3; u.pn = L & 7; u.aux = 0; return true; }
    __device__ __forceinline__ cptr a_base(const Unit& u) const { return MEMN + ((size_t)u.sub * 1024 + u.pm * 256) * 2048; }
    __device__ __forceinline__ cptr b_base(const Unit& u, int half) const { return WT + ((size_t)u.sub * 2048 + u.pn * 256 + 128 * half) * 2048; }
    __device__ __forceinline__ bool keep_acc(const Unit&) const { return false; }
    __device__ __forceinline__ void a_ready(const Unit&) const {}
    __device__ __forceinline__ void done(const Unit&) const {}
    __device__ __forceinline__ void epilogue(f32x4 (&acc)[2][2][4][2], const Unit& u, int wr, int wc, int fr, int fq) const {
        bf16_t* ob = KV + ((size_t)u.sub * 1024 + u.pm * 256 + 64 * wr) * 2048 + u.pn * 256; const unsigned lo = (unsigned)(fr * 2048 + 32 * wc + 8 * fq) * 2u;
#pragma unroll
        for (int ai = 0; ai < 2; ++ai)
#pragma unroll
            for (int m = 0; m < 4; ++m) {
#pragma unroll
                for (int bj = 0; bj < 2; ++bj) GP_ST16(ob + (size_t)(128 * ai + 16 * m) * 2048 + 128 * bj, lo, pack8(acc[ai][bj][m][0], acc[ai][bj][m][1]));
                GP_FENCE(); }
    }
};

__device__ __forceinline__ f32x4 ratio4(const f32x4 n, const f32x4 d) { f32x4 r;
#pragma unroll
    for (int j = 0; j < 4; ++j) r[j] = n[j] * __builtin_amdgcn_rcpf(fmaxf(d[j], 1e-30f));
    return r; }
struct PhOut3 {
    static constexpr int NT = 16, KB = 1024, LDA = 1024; static constexpr bool GATHER = false;
    cptr AC, WA; const float* bb; const bf16_t* G; bf16_t* MG; unsigned* pcnt; int Gd, c;
    __device__ __forceinline__ bool next(int i, Unit& u) const { const int Lt = (i / 3) * Gd + c; if (Lt >= 256) return false; tile_order(Lt, 64, 4, u.pm, u.pn); u.sub = i % 3; u.aux = 0; return true; }
    __device__ __forceinline__ cptr a_base(const Unit& u) const { return AC + (size_t)u.sub * (32 * MiB) + (size_t)u.pm * 256 * 2048; }
    __device__ __forceinline__ cptr b_base(const Unit& u, int half) const { return WA + (size_t)u.sub * (4 * MiB) + (size_t)(u.pn * 256 + 128 * half) * 2048; }
    __device__ __forceinline__ bool keep_acc(const Unit& u) const { return u.sub < 2; }
    __device__ __forceinline__ void a_ready(const Unit&) const {}
    __device__ __forceinline__ void done(const Unit& u) const { if (u.sub == 2) hook_publish(pcnt + 64 * u.pm); }
    __device__ __forceinline__ void epilogue(f32x4 (&acc)[2][2][4][2], const Unit& u, int wr, int wc, int fr, int fq) const {
        const size_t t0 = ((size_t)u.pm * 256 + 64 * wr) * 1024 + u.pn * 256; const size_t GS = (size_t)T_ROWS * 1024;
        const unsigned lo = (unsigned)(fr * 1024 + 32 * wc + 8 * fq) * 2u;
        if (u.sub < 2) {
            const bf16_t* gn = G + (u.sub == 0 ? 0 : GS) + t0; const bf16_t* gd = gn + GS; const unsigned bo = (unsigned)(32 * wc + 8 * fq) * 4u; const float* bp = bb + u.pn * 256; const float bsc = (u.sub == 1) ? 1.0f : 0.0f;
            f32x4 bv[2][2];
#pragma unroll
            for (int bj = 0; bj < 2; ++bj) { bv[bj][0] = *(const f32x4*)((const char*)(bp + 128 * bj) + bo) * bsc; bv[bj][1] = *(const f32x4*)((const char*)(bp + 128 * bj + 4) + bo) * bsc; }
#pragma unroll
            for (int ai = 0; ai < 2; ++ai) {
                u32x4 gnv[4][2], gdv[4][2];
#pragma unroll
                for (int m = 0; m < 4; ++m)
#pragma unroll
                    for (int bj = 0; bj < 2; ++bj) { const size_t o = (size_t)(128 * ai + 16 * m) * 1024 + 128 * bj; gnv[m][bj] = GP_LD16(gn + o, lo); gdv[m][bj] = GP_LD16(gd + o, lo); }
#pragma unroll
                for (int m = 0; m < 4; ++m)
#pragma unroll
                    for (int bj = 0; bj < 2; ++bj) { f32x4 n0, n1, d0, d1; unpack8(gnv[m][bj], n0, n1); unpack8(gdv[m][bj], d0, d1);
                        acc[ai][bj][m][0] = (acc[ai][bj][m][0] + bv[bj][0]) * ratio4(n0, d0); acc[ai][bj][m][1] = (acc[ai][bj][m][1] + bv[bj][1]) * ratio4(n1, d1); }
                GP_FENCE(); }
        } else {
            const bf16_t* g2 = G + 2 * GS + t0; bf16_t* ob = MG + t0;
#pragma unroll
            for (int ai = 0; ai < 2; ++ai) {
                u32x4 gv[4][2];
#pragma unroll
                for (int m = 0; m < 4; ++m)
#pragma unroll
                    for (int bj = 0; bj < 2; ++bj) gv[m][bj] = GP_LD16(g2 + (size_t)(128 * ai + 16 * m) * 1024 + 128 * bj, lo);
#pragma unroll
                for (int m = 0; m < 4; ++m)
#pragma unroll
                    for (int bj = 0; bj < 2; ++bj) { const size_t o = (size_t)(128 * ai + 16 * m) * 1024 + 128 * bj; f32x4 g0, g1; unpack8(gv[m][bj], g0, g1);
                        st16_buf(ob + o, lo, pack8(acc[ai][bj][m][0] * g0, acc[ai][bj][m][1] * g1)); }
                GP_FENCE(); }
        }
    }
};

struct PhWo {
    static constexpr int NT = 16, KB = 1024, LDA = 1024; static constexpr bool GATHER = false;
    cptr MG, WT; const float* xin_f; const bf16_t* xin_b; bf16_t* XBo; unsigned *pin, *pout, *tmo; int Gd, c;
    __device__ __forceinline__ bool next(int i, Unit& u) const { const int L = i * Gd + c; if (L >= 256) return false; tile_order(L, 64, 4, u.pm, u.pn); u.sub = 0; u.aux = 0; return true; }
    __device__ __forceinline__ cptr a_base(const Unit& u) const { return MG + (size_t)u.pm * 256 * 2048; }
    __device__ __forceinline__ cptr b_base(const Unit& u, int half) const { return WT + (size_t)(u.pn * 256 + 128 * half) * 2048; }
    __device__ __forceinline__ bool keep_acc(const Unit&) const { return false; }
    __device__ __forceinline__ void a_ready(const Unit& u) const { hook_wait(pin + 64 * u.pm, 32u, tmo); }
    __device__ __forceinline__ void done(const Unit& u) const { hook_publish(pout + 64 * u.pm); }
    __device__ __forceinline__ void epilogue(f32x4 (&acc)[2][2][4][2], const Unit& u, int wr, int wc, int fr, int fq) const {
        const size_t t0 = ((size_t)u.pm * 256 + 64 * wr) * 1024 + u.pn * 256; const unsigned lo2 = (unsigned)(fr * 1024 + 32 * wc + 8 * fq) * 2u, lo4 = lo2 * 2u;
        bf16_t* xb = XBo + t0;
        if (xin_f) {
            const float* xi = xin_f + t0;
#pragma unroll
            for (int ai = 0; ai < 2; ++ai)
#pragma unroll
                for (int mp = 0; mp < 2; ++mp) {
                    f32x4 xv[2][2][2];
#pragma unroll
                    for (int mm = 0; mm < 2; ++mm)
#pragma unroll
                        for (int bj = 0; bj < 2; ++bj) { const size_t o = (size_t)(128 * ai + 16 * (2 * mp + mm)) * 1024 + 128 * bj; xv[mm][bj][0] = *(const f32x4*)((const char*)(xi + o) + lo4); xv[mm][bj][1] = *(const f32x4*)((const char*)(xi + o + 4) + lo4); }
#pragma unroll
                    for (int mm = 0; mm < 2; ++mm)
#pragma unroll
                        for (int bj = 0; bj < 2; ++bj) { const int m = 2 * mp + mm; const size_t o = (size_t)(128 * ai + 16 * m) * 1024 + 128 * bj;
                            st16_buf(xb + o, lo2, pack8(xv[mm][bj][0] + acc[ai][bj][m][0], xv[mm][bj][1] + acc[ai][bj][m][1])); }
                    GP_FENCE(); }
        } else {
            const bf16_t* xi = xin_b + t0;
#pragma unroll
            for (int ai = 0; ai < 2; ++ai) {
                u32x4 xv[4][2];
#pragma unroll
                for (int m = 0; m < 4; ++m)
#pragma unroll
                    for (int bj = 0; bj < 2; ++bj) xv[m][bj] = GP_LD16(xi + (size_t)(128 * ai + 16 * m) * 1024 + 128 * bj, lo2);
#pragma unroll
                for (int m = 0; m < 4; ++m)
#pragma unroll
                    for (int bj = 0; bj < 2; ++bj) { f32x4 x0, x1; unpack8(xv[m][bj], x0, x1);
                        st16_buf(xb + (size_t)(128 * ai + 16 * m) * 1024 + 128 * bj, lo2, pack8(x0 + acc[ai][bj][m][0], x1 + acc[ai][bj][m][1])); }
                GP_FENCE(); }
        }
    }
};

struct MoeTab { const LAS int* tp; const LAS int* cn; };
__device__ __forceinline__ void moe_unit(const MoeTab& tb, int uidx, Unit& u) {
    const int tile = uidx >> 2; int e = 0;
    for (int k = 0; k < 32; ++k) if (__builtin_amdgcn_readfirstlane(tb.tp[k + 1]) <= tile) e = k + 1;
    const int tpe = __builtin_amdgcn_readfirstlane(tb.tp[e]);
    u.sub = e; u.pm = tile - tpe; u.pn = uidx & 3; u.aux = tpe;
}
constexpr unsigned MOE_SPIN_CAP = 1u << 20;
struct PhMoeGU {
    static constexpr int NT = 16, KB = 1024, LDA = 1024; static constexpr bool GATHER = true;
    cptr XB, WT; const int* list; const float* rsl; bf16_t* HID; unsigned* tcnt; MoeTab tb; int Gd, c;
    __device__ __forceinline__ bool next(int i, Unit& u) const { const int total = __builtin_amdgcn_readfirstlane(tb.tp[32]) * 4; const int L = i * Gd + c; if (L >= total) return false; moe_unit(tb, L, u); return true; }
    __device__ __forceinline__ cptr a_base(const Unit&) const { return XB; }
    __device__ __forceinline__ void a_offs(const Unit& u, int tid, unsigned (&off)[2][2]) const {
        const int n = __builtin_amdgcn_readfirstlane(tb.cn[u.sub]) - u.pm * 256; const int* lp = list + u.sub * 16384 + u.pm * 256;
#pragma unroll
        for (int i = 0; i < 2; ++i) { int R, C; stage_rc(tid * 16 + i * 8192, R, C);
#pragma unroll
            for (int h = 0; h < 2; ++h) { int idx = 128 * h + R; idx = idx < n ? idx : 0; const int tok = lp[idx]; off[h][i] = (unsigned)(tok * 1024 + C) * 2u; } }
    }
    __device__ __forceinline__ cptr b_base(const Unit& u, int half) const { return WT + ((size_t)u.sub * 1024 + (half ? 512 : 0) + 128 * u.pn) * 2048; }
    __device__ __forceinline__ bool keep_acc(const Unit&) const { return false; }
    __device__ __forceinline__ void a_ready(const Unit&) const {}
    __device__ __forceinline__ void done(const Unit& u) const {
        asm volatile("s_waitcnt vmcnt(0)" ::: "memory");
        if ((threadIdx.x & 63) == 0) __hip_atomic_fetch_add(tcnt + 64 * (u.aux + u.pm), 1u, __ATOMIC_RELAXED, __HIP_MEMORY_SCOPE_AGENT);
    }
    __device__ __forceinline__ void epilogue(f32x4 (&acc)[2][2][4][2], const Unit& u, int wr, int wc, int fr, int fq) const {
        const int n = __builtin_amdgcn_readfirstlane(tb.cn[u.sub]) - u.pm * 256; const float* rp = rsl + u.sub * 16384 + u.pm * 256;
        bf16_t* ob = HID + ((size_t)(u.aux + u.pm) * 256 + 64 * wr) * 512 + 128 * u.pn; const unsigned lo = (unsigned)(fr * 512 + 32 * wc + 8 * fq) * 2u;
        float rsv[2][4];
#pragma unroll
        for (int ai = 0; ai < 2; ++ai)
#pragma unroll
            for (int m = 0; m < 4; ++m) { int idx = 128 * ai + 64 * wr + 16 * m + fr; idx = idx < n ? idx : 0; rsv[ai][m] = rp[idx]; }
#pragma unroll
        for (int ai = 0; ai < 2; ++ai)
#pragma unroll
            for (int m = 0; m < 4; ++m) { const float s = rsv[ai][m];
                const f32x4 g0 = acc[ai][0][m][0] * s, g1 = acc[ai][0][m][1] * s;
                st16_buf(ob + (size_t)(128 * ai + 16 * m) * 512, lo, pack8(g0 * sigm4(g0) * (acc[ai][1][m][0] * s), g1 * sigm4(g1) * (acc[ai][1][m][1] * s))); GP_FENCE(); }
    }
};
struct PhMoeDn {
    static constexpr int NT = 8, KB = 512, LDA = 512; static constexpr bool GATHER = false;
    cptr HID, WT; bf16_t* Y; unsigned* tcnt; unsigned* tmo; MoeTab tb; int Gd, c;
    __device__ __forceinline__ bool next(int i, Unit& u) const {
        const int n = __builtin_amdgcn_readfirstlane(tb.tp[32]) * 4, H = n % Gd, nl = Gd - H, A = (H == 0) ? 0 : (n < 2 * nl ? n : 2 * nl);
        int na = 0; if (c >= H && H != 0) { const int li = c - H; na = (li < A ? 1 : 0) + (li + nl < A ? 1 : 0); }
        int uidx; if (i < na) uidx = (c - H) + i * nl; else { uidx = A + c + Gd * (i - na); if (uidx >= n) return false; }
        moe_unit(tb, uidx, u); return true;
    }
    __device__ __forceinline__ cptr a_base(const Unit& u) const { return HID + (size_t)(u.aux + u.pm) * 256 * 1024; }
    __device__ __forceinline__ cptr b_base(const Unit& u, int half) const { return WT + ((size_t)u.sub * 1024 + 256 * u.pn + 128 * half) * 1024; }
    __device__ __forceinline__ bool keep_acc(const Unit&) const { return false; }
    __device__ __forceinline__ void a_ready(const Unit& u) const {
        if (threadIdx.x < 64) {
            unsigned* p = tcnt + 64 * (u.aux + u.pm); unsigned spins = 0;
            while ((unsigned)__builtin_amdgcn_readfirstlane(__hip_atomic_load(p, __ATOMIC_RELAXED, __HIP_MEMORY_SCOPE_AGENT)) < 32u) {
                if ((++spins & 255u) == 0u && (__builtin_amdgcn_readfirstlane(__hip_atomic_load(tmo, __ATOMIC_RELAXED, __HIP_MEMORY_SCOPE_AGENT)) != 0u || spins > MOE_SPIN_CAP)) { if (threadIdx.x == 0) __hip_atomic_store(tmo, 1u, __ATOMIC_RELAXED, __HIP_MEMORY_SCOPE_AGENT); break; }
                __builtin_amdgcn_s_sleep(2); }
            __builtin_amdgcn_fence(__ATOMIC_ACQUIRE, "agent");
            asm volatile("s_waitcnt vmcnt(0)" ::: "memory");
        }
        asm volatile("" ::: "memory"); __builtin_amdgcn_s_barrier(); asm volatile("" ::: "memory");
    }
    __device__ __forceinline__ void done(const Unit&) const {}
    __device__ __forceinline__ void epilogue(f32x4 (&acc)[2][2][4][2], const Unit& u, int wr, int wc, int fr, int fq) const {
        bf16_t* ob = Y + ((size_t)(u.aux + u.pm) * 256 + 64 * wr) * 1024 + 256 * u.pn; const unsigned lo = (unsigned)(fr * 1024 + 32 * wc + 8 * fq) * 2u;
#pragma unroll
        for (int ai = 0; ai < 2; ++ai)
#pragma unroll
            for (int m = 0; m < 4; ++m) {
#pragma unroll
                for (int bj = 0; bj < 2; ++bj) GP_ST16(ob + (size_t)(128 * ai + 16 * m) * 1024 + 128 * bj, lo, pack8(acc[ai][bj][m][0], acc[ai][bj][m][1]));
                GP_FENCE(); }
    }
};
}
namespace tp {
using ge::f32x4; using ge::u32x4; using ge::bf16x8;
typedef float f32x2 __attribute__((ext_vector_type(2)));
typedef unsigned u32x2 __attribute__((ext_vector_type(2)));
typedef short s16x4 __attribute__((ext_vector_type(4)));
#define LDS_WAIT() asm volatile("s_waitcnt lgkmcnt(0)" ::: "memory")
__device__ __forceinline__ float wave_sum(float v) {
#pragma unroll
    for (int o = 1; o < 64; o <<= 1) v += __shfl_xor(v, o);
    return v;
}
template <int CTRL> __device__ __forceinline__ float dpp_f(float v) { return __int_as_float(__builtin_amdgcn_update_dpp(0, __float_as_int(v), CTRL, 0xF, 0xF, true)); }
__device__ __forceinline__ float row_sum16(float v) {
    v += dpp_f<0xB1>(v); v += dpp_f<0x4E>(v); v += dpp_f<0x141>(v); v += dpp_f<0x140>(v); return v; }
__device__ __forceinline__ float wave_total(float v) {
    v = row_sum16(v);
    return (__int_as_float(__builtin_amdgcn_readlane(__float_as_int(v), 0)) + __int_as_float(__builtin_amdgcn_readlane(__float_as_int(v), 16)))
         + (__int_as_float(__builtin_amdgcn_readlane(__float_as_int(v), 32)) + __int_as_float(__builtin_amdgcn_readlane(__float_as_int(v), 48))); }
__device__ __forceinline__ unsigned pk2(float lo, float hi) { return ge::cvt_pk_bf16(lo, hi); }
__device__ __forceinline__ float blo(unsigned w) { return __uint_as_float(w << 16); }
__device__ __forceinline__ float bhi(unsigned w) { return __uint_as_float(w & 0xffff0000u); }

typedef const GAS float* const __attribute__((address_space(4)))* KIn;
constexpr int IT_IN = 16 * 288, IT_SQ = 512, IT_KV = 1024, IT_GU = 32 * 512, IT_DN = 32 * 256, IT_LAYER = IT_IN + 4 * IT_SQ + IT_KV + IT_GU + IT_DN;
struct ItemDesc { const float* W; bf16_t* WT; const float* gk; int K, N, k0, n0; };
__device__ __forceinline__ ItemDesc p0_decode(KIn in, unsigned char* ws, int it) {
    ItemDesc d; const int l = it / IT_LAYER; int r = it % IT_LAYER; int item, ii, gi = -1; size_t so, wo; d.K = 1024; d.N = 1024;
    if (r < IT_IN) { ii = 4; so = (size_t)l * 1024 * 9216; d.N = 9216; wo = W_IN + (size_t)l * 18 * MiB; gi = 2; item = r; }
    else if ((r -= IT_IN) < 4 * IT_SQ) { const int q = r >> 9; item = r & 511; ii = q == 0 ? 7 : q == 1 ? 13 : q == 2 ? 16 : 17; so = (size_t)l * 1048576; wo = W_OA + (size_t)q * 4 * MiB + (size_t)l * 2 * MiB; }
    else if ((r -= 4 * IT_SQ) < IT_KV) { ii = 15; so = (size_t)l * 2097152; d.N = 2048; wo = W_KV + (size_t)l * 4 * MiB; item = r; }
    else if ((r -= IT_KV) < IT_GU) { const int e = r >> 9; ii = 23; so = ((size_t)l * 32 + e) * 1048576; wo = W_GU + ((size_t)l * 32 + e) * 2 * MiB; gi = 18; item = r & 511; }
    else { r -= IT_GU; const int e = r >> 8; ii = 24; so = ((size_t)l * 32 + e) * 524288; d.K = 512; wo = W_DN + ((size_t)l * 32 + e) * MiB; item = r & 255; }
    d.W = (const float*)in[ii] + so; d.WT = (bf16_t*)(ws + wo); d.gk = gi >= 0 ? (const float*)in[gi] + l * 1024 : nullptr;
    const int nblk = d.N / 32; d.k0 = 64 * (item / nblk); d.n0 = 32 * (item % nblk); return d;
}
struct ItemRt { const float* src; bf16_t* dst; const float* gk; unsigned N4, K2; bool hg; };
__device__ __forceinline__ ItemRt p0_rt(const ItemDesc& d) { ItemRt r; r.src = d.W + (size_t)d.k0 * d.N + d.n0; r.dst = d.WT + (size_t)d.n0 * d.K + d.k0; r.hg = d.gk != nullptr; r.gk = r.hg ? d.gk + d.k0 : d.W; r.N4 = (unsigned)d.N * 4u; r.K2 = (unsigned)d.K * 2u; return r; }
__device__ __forceinline__ void p0_load(const ItemRt& r, int lane, f32x4 (&tv)[8], f32x4 (&g)[2]) {
    const unsigned lo = (unsigned)(lane >> 3) * 8u * r.N4 + (unsigned)(lane & 7) * 16u;
#pragma unroll
    for (int i = 0; i < 8; ++i) tv[i] = __builtin_nontemporal_load((const f32x4*)((const char*)r.src + (size_t)i * r.N4 + lo));
    g[0] = *(const f32x4*)((const char*)r.gk + (unsigned)(lane >> 3) * 32u); g[1] = *(const f32x4*)((const char*)r.gk + 16 + (unsigned)(lane >> 3) * 32u);
}
__device__ __forceinline__ void p0_store(const ItemRt& r, int lane, f32x4 (&tv)[8], const f32x4 (&g)[2]) {
    if (r.hg) { tv[0] *= g[0].x; tv[1] *= g[0].y; tv[2] *= g[0].z; tv[3] *= g[0].w; tv[4] *= g[1].x; tv[5] *= g[1].y; tv[6] *= g[1].z; tv[7] *= g[1].w; }
    const unsigned so = (unsigned)(lane & 7) * 4u * r.K2 + (unsigned)(lane >> 3) * 16u;
#pragma unroll
    for (int j = 0; j < 4; ++j) { u32x4 o; o.x = pk2(tv[0][j], tv[1][j]); o.y = pk2(tv[2][j], tv[3][j]); o.z = pk2(tv[4][j], tv[5][j]); o.w = pk2(tv[6][j], tv[7][j]);
        __builtin_nontemporal_store(o, (u32x4*)((char*)r.dst + (size_t)j * r.K2 + so)); }
}
constexpr int IT_EARLY = IT_IN + 2 * IT_KV, IT_LATE = 2 * IT_LAYER - IT_EARLY;
__device__ __forceinline__ int p0_early_item(int e) { return e < IT_IN ? e : (e < IT_IN + IT_KV ? e + 4 * IT_SQ : IT_LAYER + IT_IN + 4 * IT_SQ + (e - IT_IN - IT_KV)); }
__device__ __forceinline__ int p0_late_item(int j) {
    if (j < 4 * IT_SQ) return IT_IN + j;
    j -= 4 * IT_SQ; if (j < IT_GU + IT_DN) return IT_IN + 4 * IT_SQ + IT_KV + j;
    j -= IT_GU + IT_DN; if (j < IT_IN + 4 * IT_SQ) return IT_LAYER + j;
    j -= IT_IN + 4 * IT_SQ; return IT_LAYER + IT_IN + 4 * IT_SQ + IT_KV + j;
}
template <int WHICH  >
__device__ __forceinline__ void p0_items(KIn in, unsigned char* ws, int first, int stride, int lane) {
    constexpr int COUNT = WHICH == 0 ? 2 * IT_LAYER : WHICH == 1 ? IT_EARLY : IT_LATE;
#define P0_MAP(i) (WHICH == 0 ? (i) : WHICH == 1 ? p0_early_item(i) : p0_late_item(i))
    f32x4 t0[8], t1[8], t2[8], t3[8], g0[2], g1[2], g2[2], g3[2]; ItemRt r0, r1, r2, r3; int it = first;
#define P0_ISSUE(s, idx) { const int ii_ = (idx) < COUNT ? (idx) : COUNT - 1; r##s = p0_rt(p0_decode(in, ws, P0_MAP(ii_))); p0_load(r##s, lane, t##s, g##s); }
#define P0_STEP(s) { if (it < COUNT) p0_store(r##s, lane, t##s, g##s); P0_ISSUE(s, it + 4 * stride) it += stride; }
    P0_ISSUE(0, it) P0_ISSUE(1, it + stride) P0_ISSUE(2, it + 2 * stride) P0_ISSUE(3, it + 3 * stride)
    while (it < COUNT) { P0_STEP(0) P0_STEP(1) P0_STEP(2) P0_STEP(3) }
#undef P0_STEP
#undef P0_ISSUE
#undef P0_MAP
}
__device__ __forceinline__ void p0_prologue(KIn in, unsigned char* ws, int gw, int NGW, int lane, bool background) {
    if (background) p0_items<1>(in, ws, gw, NGW, lane); else p0_items<0>(in, ws, gw, NGW, lane);
    asm volatile("" : "+s"(in), "+s"(ws));
    { const float *w_group = (const float*)in[19], *w_router = (const float*)in[21], *ffn_g = (const float*)in[18]; bf16_t* WRT = (bf16_t*)(ws + W_RT);
      for (int i = gw * 64 + lane; i < 2 * 48 * 1024; i += NGW * 64) { const int l = i / 49152, r = i % 49152, j = r >> 10, k = r & 1023;
        float w = 0.f; if (j < 4) w = w_group[((size_t)l * 1024 + k) * 4 + j]; else if (j < 36) w = w_router[((size_t)l * 1024 + k) * 32 + (j - 4)];
        w *= ffn_g[l * 1024 + k]; const unsigned hb = pk2(w, 0.f) & 0xffffu; const float hf = __uint_as_float(hb << 16);
        WRT[(size_t)l * 98304 + r] = (bf16_t)hb; WRT[(size_t)l * 98304 + 49152 + r] = (bf16_t)(pk2(w - hf, 0.f) & 0xffffu); } }
    asm volatile("" : "+s"(in), "+s"(ws));
    { const float* x = (const float*)in[0]; float* RS = (float*)(ws + WS_RT + RT_RS); bf16_t* XB = (bf16_t*)(ws + WS_XB);
      for (int row = gw; row < T_ROWS; row += 2 * NGW) { const int row2 = row + NGW;
        const f32x4* xr = (const f32x4*)(x + (size_t)row * 1024) + lane; const f32x4* xr2 = (const f32x4*)(x + (size_t)(row2 < T_ROWS ? row2 : row) * 1024) + lane; f32x4 v[4], v2[4]; float s = 0.f, s2 = 0.f;
#pragma unroll
        for (int j = 0; j < 4; ++j) v[j] = xr[64 * j];
#pragma unroll
        for (int j = 0; j < 4; ++j) v2[j] = xr2[64 * j];
#pragma unroll
        for (int j = 0; j < 4; ++j) { s += (v[j].x * v[j].x + v[j].y * v[j].y) + (v[j].z * v[j].z + v[j].w * v[j].w); s2 += (v2[j].x * v2[j].x + v2[j].y * v2[j].y) + (v2[j].z * v2[j].z + v2[j].w * v2[j].w); }
        s = wave_sum(s); s2 = wave_sum(s2); const float rstd = rsqrtf(s * (1.0f / 1024.0f) + 1e-6f), rstd2 = rsqrtf(s2 * (1.0f / 1024.0f) + 1e-6f);
        if (lane == 0) RS[row] = rstd;
        u32x2* o = (u32x2*)(XB + (size_t)row * 1024) + lane;
#pragma unroll
        for (int j = 0; j < 4; ++j) { u32x2 w; w.x = pk2(v[j].x * rstd, v[j].y * rstd); w.y = pk2(v[j].z * rstd, v[j].w * rstd); o[64 * j] = w; }
        if (row2 < T_ROWS) { if (lane == 0) RS[row2] = rstd2; u32x2* o2 = (u32x2*)(XB + (size_t)row2 * 1024) + lane;
#pragma unroll
            for (int j = 0; j < 4; ++j) { u32x2 w; w.x = pk2(v2[j].x * rstd2, v2[j].y * rstd2); w.y = pk2(v2[j].z * rstd2, v2[j].w * rstd2); o2[64 * j] = w; } } } }
    asm volatile("" : "+s"(in), "+s"(ws));
    { const float *mem = (const float*)in[1], *mem_g = (const float*)in[3]; bf16_t* MEMN = (bf16_t*)(ws + WS_MEMN);
      for (int rr = gw; rr < 2048; rr += NGW) { const int l = rr >> 10, row = rr & 1023; const f32x4* xr = (const f32x4*)(mem + (size_t)row * 1024) + lane; const f32x4* gr = (const f32x4*)(mem_g + l * 1024) + lane; f32x4 v[4]; float s = 0.f;
#pragma unroll
        for (int j = 0; j < 4; ++j) { v[j] = xr[64 * j]; s += (v[j].x * v[j].x + v[j].y * v[j].y) + (v[j].z * v[j].z + v[j].w * v[j].w); }
        s = wave_sum(s); const float rstd = rsqrtf(s * (1.0f / 1024.0f) + 1e-6f);
        u32x2* o = (u32x2*)(MEMN + ((size_t)l * 1024 + row) * 1024) + lane;
#pragma unroll
        for (int j = 0; j < 4; ++j) { const f32x4 g = gr[64 * j]; u32x2 w; w.x = pk2(v[j].x * rstd * g.x, v[j].y * rstd * g.y); w.y = pk2(v[j].z * rstd * g.z, v[j].w * rstd * g.w); o[64 * j] = w; } } }
}

__device__ __forceinline__ void aconv_phase(const bf16_t* CV, const bf16_t* GB, const float* w, bf16_t* AC, int vcu, int G, int tid) {
    int c = 8 * (tid & 127); asm volatile("" : "+v"(c));
    const unsigned co2 = (unsigned)c * 2u, co4 = (unsigned)c * 4u; const int sub = __builtin_amdgcn_readfirstlane(tid >> 7);
    const f32x4 w0a = *(const f32x4*)((const char*)w + co4), w0b = *(const f32x4*)((const char*)(w + 4) + co4), w1a = *(const f32x4*)((const char*)(w + 1024) + co4), w1b = *(const f32x4*)((const char*)(w + 1028) + co4),
                w2a = *(const f32x4*)((const char*)(w + 2048) + co4), w2b = *(const f32x4*)((const char*)(w + 2052) + co4);
    for (int blk = vcu * 4 + sub; blk < 2048; blk += G * 4) {
        const size_t row0 = (size_t)blk * 8; const bool first = ((row0 & 4095) == 0);
        const bf16_t* cvu = CV + row0 * 1024; const bf16_t* gbu = GB + row0 * 1024; bf16_t* acu = AC + row0 * 1024;
        f32x4 p2a = {0.f, 0.f, 0.f, 0.f}, p2b = p2a, p1a = p2a, p1b = p2a;
        if (!first) { ge::unpack8(*(const u32x4*)((const char*)(cvu - 2048) + co2), p2a, p2b); ge::unpack8(*(const u32x4*)((const char*)(cvu - 1024) + co2), p1a, p1b); }
#pragma unroll
        for (int j = 0; j < 8; ++j) { f32x4 ca, cb, ga, gb; ge::unpack8(*(const u32x4*)((const char*)(cvu + j * 1024) + co2), ca, cb); ge::unpack8(*(const u32x4*)((const char*)(gbu + j * 1024) + co2), ga, gb);
            const f32x4 sa = w0a * p2a + w1a * p1a + w2a * ca, sb = w0b * p2b + w1b * p1b + w2b * cb;
            *(u32x4*)((char*)(acu + j * 1024) + co2) = ge::pack8(ga * sa, gb * sb);
            p2a = p1a; p2b = p1b; p1a = ca; p1b = cb; }
    }
}

__device__ __forceinline__ void bconv_phase(const bf16_t* U, const float* w, const float* cb, const float* lg, const float* lb, bf16_t* UB, LAS unsigned char* lds, int vcu, int G, int tid) {
    LAS float* red = (LAS float*)lds;
    int par = 0;
    int c0 = 2 * tid; asm volatile("" : "+v"(c0));
    const unsigned co2 = (unsigned)c0 * 2u, co4 = (unsigned)c0 * 4u;
    const int wave = __builtin_amdgcn_readfirstlane(tid >> 6);
    f32x2 wk[31];
#pragma unroll
    for (int k = 0; k < 31; ++k) wk[k] = *(const f32x2*)((const char*)(w + k * 1024) + co4);
    const f32x2 cbv = *(const f32x2*)((const char*)cb + co4), lgv = *(const f32x2*)((const char*)lg + co4), lbv = *(const f32x2*)((const char*)lb + co4);
    for (int grp = vcu; grp < T_ROWS / 64; grp += G) {
        const size_t row0 = (size_t)grp * 64; const bool first = ((row0 & 4095) == 0);
        int lane = tid & 63; asm volatile("" : "+v"(lane));
        unsigned uu[46], nx[16];
#pragma unroll
        for (int i = 0; i < 30; ++i) { uu[i] = 0u; if (!first) uu[i] = *(const unsigned*)((const char*)(U + (row0 + i - 30) * 1024) + co2); }
#pragma unroll
        for (int i = 30; i < 46; ++i) uu[i] = *(const unsigned*)((const char*)(U + (row0 + i - 30) * 1024) + co2);
#pragma unroll
        for (int sub = 0; sub < 4; ++sub) {
            const size_t r0 = row0 + 16 * sub;
            if (sub < 3) {
#pragma unroll
                for (int i = 0; i < 16; ++i) nx[i] = *(const unsigned*)((const char*)(U + (r0 + 16 + i) * 1024) + co2); }
            f32x2 acc[16];
#pragma unroll
            for (int j = 0; j < 16; ++j) acc[j] = cbv;
#pragma unroll
            for (int i = 0; i < 46; ++i) { const float lo = blo(uu[i]), hi = bhi(uu[i]);
#pragma unroll
                for (int j = 0; j < 16; ++j) { const int k = i - j; if (k >= 0 && k < 31) { acc[j].x += wk[k].x * lo; acc[j].y += wk[k].y * hi; } } }
            { float s1[16], s2[8];
#pragma unroll
              for (int i = 0; i < 16; ++i) { const float a0 = acc[i].x + acc[i].y, a1 = acc[i].x * acc[i].x + acc[i].y * acc[i].y;
                  auto rr = __builtin_amdgcn_permlane32_swap(__float_as_uint(a0), __float_as_uint(a1), false, false); s1[i] = __uint_as_float(rr[0]) + __uint_as_float(rr[1]); }
#pragma unroll
              for (int i = 0; i < 8; ++i) { auto rr = __builtin_amdgcn_permlane16_swap(__float_as_uint(s1[i]), __float_as_uint(s1[i + 8]), false, false); s2[i] = row_sum16(__uint_as_float(rr[0]) + __uint_as_float(rr[1])); }
              if ((lane & 15) == 0) { LAS f32x4* rw = (LAS f32x4*)(red + par * 256 + wave * 32 + 8 * (lane >> 4)); rw[0] = f32x4{s2[0], s2[1], s2[2], s2[3]}; rw[1] = f32x4{s2[4], s2[5], s2[6], s2[7]}; } }
            __syncthreads();
            float fsum = 0.f;
#pragma unroll
            for (int wv = 0; wv < 8; ++wv) fsum += red[par * 256 + wv * 32 + (lane & 31)];
            par ^= 1;
            float mu_l, rstd_l;
            { auto rr = __builtin_amdgcn_permlane16_swap(__float_as_uint(fsum), __float_as_uint(fsum), false, false);
              mu_l = __uint_as_float(rr[0]) * (1.0f / 1024.0f); const float var = __uint_as_float(rr[1]) * (1.0f / 1024.0f) - mu_l * mu_l; rstd_l = rsqrtf(fmaxf(var, 0.f) + 1e-6f); }
#pragma unroll
            for (int j = 0; j < 16; ++j) { const float mu = __int_as_float(__builtin_amdgcn_readlane(__float_as_int(mu_l), j)), rstd = __int_as_float(__builtin_amdgcn_readlane(__float_as_int(rstd_l), j));
                const float y0 = (acc[j].x - mu) * (rstd * lgv.x) + lbv.x, y1 = (acc[j].y - mu) * (rstd * lgv.y) + lbv.y;
                *(unsigned*)((char*)(UB + (r0 + j) * 1024) + co2) = pk2(y0 * ge::fsigm(y0), y1 * ge::fsigm(y1)); }
            if (sub < 3) {
#pragma unroll
                for (int i = 0; i < 30; ++i) uu[i] = uu[i + 16];
#pragma unroll
                for (int i = 0; i < 16; ++i) uu[30 + i] = nx[i]; }
        }
    }
    __syncthreads();
}

constexpr int ATT_PITCH = 544;
constexpr int ATT_LDS = 256 * ATT_PITCH;
__device__ __forceinline__ void att_load(const bf16_t* src  , int half, int tid, u32x4 (&v)[8]) {
    const unsigned go = (unsigned)((tid >> 5) * 2048 + (tid & 31) * 8) * 2u;
#pragma unroll
    for (int it = 0; it < 8; ++it) v[it] = *(const u32x4*)((const char*)(src + (size_t)(it + 8 * half) * 16 * 2048) + go);
}
__device__ __forceinline__ void att_store(LAS unsigned char* lds, int half, int tid, const u32x4 (&v)[8]) {
    const unsigned lo = (unsigned)((tid >> 5) * ATT_PITCH + (tid & 31) * 16);
#pragma unroll
    for (int it = 0; it < 8; ++it) *(LAS u32x4*)(lds + lo + (it + 8 * half) * 16 * ATT_PITCH) = v[it];
}
__device__ __forceinline__ void attn_phase(const bf16_t* Q, const bf16_t* KV, bf16_t* O, LAS unsigned char* lds, int vcu, int G, int tid) {
    int lane = tid & 63; asm volatile("" : "+v"(lane));
    const int wave = __builtin_amdgcn_readfirstlane(tid >> 6), l15 = lane & 15, kg = lane >> 4;
    const unsigned qlo = (unsigned)(l15 * 1024 + 8 * kg) * 2u, olo = (unsigned)(l15 * 1024 + 4 * kg) * 2u;
    const int klo = l15 * ATT_PITCH + 16 * kg;
    const int trb = (4 * kg + (l15 >> 2)) * ATT_PITCH + (4 * (l15 & 3)) * 2;
    for (int unit = vcu; unit < 256; unit += G) {
        const int b = unit >> 6, h = (unit >> 4) & 3, qb = unit & 15;
        const size_t row0 = (size_t)b * 4096 + qb * 256 + 32 * wave;
        const bf16_t* kvb = KV + (size_t)(b * 256) * 2048 + h * 256;
        bf16x8 qf[2][8];
        { u32x4 ka[8], kb2[8]; att_load(kvb, 0, tid, ka); att_load(kvb, 1, tid, kb2);
#pragma unroll
          for (int g = 0; g < 2; ++g) { const bf16_t* qu = Q + (row0 + 16 * g) * 1024 + h * 256;
#pragma unroll
              for (int ks = 0; ks < 8; ++ks) qf[g][ks] = *(const bf16x8*)((const char*)(qu + 32 * ks) + qlo); }
          att_store(lds, 0, tid, ka); att_store(lds, 1, tid, kb2); }
        __syncthreads();
        bf16x8 pf[2][8]; float linv[2];
        f32x4 S[2][16];
#pragma unroll
        for (int kb = 0; kb < 16; ++kb) { f32x4 s0 = {0.f, 0.f, 0.f, 0.f}, s1 = s0;
#pragma unroll
            for (int ks = 0; ks < 8; ++ks) { const bf16x8 kf = *(const LAS bf16x8*)(lds + klo + kb * 16 * ATT_PITCH + ks * 64);
                s0 = __builtin_amdgcn_mfma_f32_16x16x32_bf16(kf, qf[0][ks], s0, 0, 0, 0); s1 = __builtin_amdgcn_mfma_f32_16x16x32_bf16(kf, qf[1][ks], s1, 0, 0, 0); }
            S[0][kb] = s0; S[1][kb] = s1; if (kb & 1) __builtin_amdgcn_sched_barrier(0); }
        u32x4 va[8], vb[8]; att_load(kvb + 1024, 0, tid, va);
#pragma unroll
        for (int g = 0; g < 2; ++g) {
            if (g == 1) att_load(kvb + 1024, 1, tid, vb);
            float m = S[g][0][0];
#pragma unroll
            for (int kb = 0; kb < 16; ++kb)
#pragma unroll
                for (int r = 0; r < 4; ++r) m = fmaxf(m, S[g][kb][r]);
            m = fmaxf(m, __shfl_xor(m, 16)); m = fmaxf(m, __shfl_xor(m, 32));
            float l = 0.f;
#pragma unroll
            for (int kb = 0; kb < 16; ++kb)
#pragma unroll
                for (int r = 0; r < 4; ++r) { const float p = __builtin_amdgcn_exp2f((S[g][kb][r] - m) * 0.09016844005556021f); S[g][kb][r] = p; l += p; }
            l += __shfl_xor(l, 16); l += __shfl_xor(l, 32);
            linv[g] = 1.0f / l;
#pragma unroll
            for (int kk = 0; kk < 8; ++kk) { const u32x4 w = ge::pack8(S[g][2 * kk], S[g][2 * kk + 1]); pf[g][kk] = __builtin_bit_cast(bf16x8, w); }
            __builtin_amdgcn_sched_barrier(0);
        }
        __syncthreads();
        att_store(lds, 0, tid, va); att_store(lds, 1, tid, vb);
        __syncthreads();
        bf16_t* ou = O + row0 * 1024 + h * 256;
#pragma unroll 1
        for (int db = 0; db < 16; ++db) { f32x4 o0 = {0.f, 0.f, 0.f, 0.f}, o1 = o0;
#pragma unroll
            for (int kk = 0; kk < 8; ++kk) { const LAS unsigned char* p = lds + trb + (32 * kk) * ATT_PITCH + db * 32;
                const s16x4 lo = __builtin_bit_cast(s16x4, __builtin_amdgcn_ds_read_tr16_b64_v4i16((LAS s16x4*)p));
                const s16x4 hi = __builtin_bit_cast(s16x4, __builtin_amdgcn_ds_read_tr16_b64_v4i16((LAS s16x4*)(p + 16 * ATT_PITCH)));
                const bf16x8 vf = __builtin_shufflevector(lo, hi, 0, 1, 2, 3, 4, 5, 6, 7);
                o0 = __builtin_amdgcn_mfma_f32_16x16x32_bf16(vf, pf[0][kk], o0, 0, 0, 0); o1 = __builtin_amdgcn_mfma_f32_16x16x32_bf16(vf, pf[1][kk], o1, 0, 0, 0); }
            u32x2 w0, w1; w0.x = pk2(o0[0] * linv[0], o0[1] * linv[0]); w0.y = pk2(o0[2] * linv[0], o0[3] * linv[0]); w1.x = pk2(o1[0] * linv[1], o1[1] * linv[1]); w1.y = pk2(o1[2] * linv[1], o1[3] * linv[1]);
            *(u32x2*)((char*)(ou + 16 * db) + olo) = w0; *(u32x2*)((char*)(ou + 16 * 1024 + 16 * db) + olo) = w1; }
        __syncthreads();
    }
}

struct RouteArgs { unsigned* pcnt; unsigned* tmo; const bf16_t* X; const bf16_t* WR; const float* bg; const float* br; float* RS; int* tok_e; int* tok_pos; float* tok_w; int* cnt; int* list; float* rsl; };
constexpr int RT_PITCH = 1040;
__device__ __forceinline__ void route_phase(const RouteArgs& a, LAS unsigned char* lds, int vcu, int G, int tid) {
    const int wave = __builtin_amdgcn_readfirstlane(tid >> 6), blk = wave >> 1, kh = wave & 1;
    int lane = tid & 63; asm volatile("" : "+v"(lane));
    const int l15 = lane & 15, kg = lane >> 4;
    LAS unsigned char* WH = lds; LAS unsigned char* WL = lds + 36 * RT_PITCH;
    LAS float* ex = (LAS float*)(lds + 2 * 36 * RT_PITCH);
    LAS float* T = ex + 4 * 13 * 64;
    LAS float* SS = T + 64 * 49;
    const unsigned xo = (unsigned)(l15 * 1024 + 8 * kg) * 2u;
    int brow[3];
#pragma unroll
    for (int nb = 0; nb < 3; ++nb) { const int r = 16 * nb + l15; brow[nb] = (r < 36 ? r : 35) * RT_PITCH + 16 * kg; }
    for (int grp = vcu; grp < T_ROWS / 64; grp += G) {
        if (a.pcnt) {
            if (tid < 64) { unsigned* p = a.pcnt + 64 * (grp >> 2); unsigned spins = 0;
                while ((unsigned)__builtin_amdgcn_readfirstlane(__hip_atomic_load(p, __ATOMIC_RELAXED, __HIP_MEMORY_SCOPE_AGENT)) < 32u) {
                    if ((++spins & 255u) == 0u && (__builtin_amdgcn_readfirstlane(__hip_atomic_load(a.tmo, __ATOMIC_RELAXED, __HIP_MEMORY_SCOPE_AGENT)) != 0u || spins > (1u << 20))) { if (tid == 0) __hip_atomic_store(a.tmo, 1u, __ATOMIC_RELAXED, __HIP_MEMORY_SCOPE_AGENT); break; }
                    __builtin_amdgcn_s_sleep(2); }
                __builtin_amdgcn_fence(__ATOMIC_ACQUIRE, "agent"); asm volatile("s_waitcnt vmcnt(0)" ::: "memory"); }
            __syncthreads(); }
        f32x4 acc[3]; float ss = 0.f;
#pragma unroll
        for (int nb = 0; nb < 3; ++nb) acc[nb] = (f32x4){0.f, 0.f, 0.f, 0.f};
#pragma unroll
        for (int st = 0; st < 2; ++st) {
            const bf16_t* xu = a.X + ((size_t)grp * 64 + 16 * blk) * 1024 + 512 * st + 256 * kh;
            u32x4 xa[8];
#pragma unroll
            for (int i = 0; i < 8; ++i) xa[i] = *(const u32x4*)((const char*)(xu + 32 * i) + xo);
#pragma unroll
            for (int it = 0; it < 9; ++it) { const int c = tid + 512 * it, part = c / 2304, rr = (c % 2304) >> 6, cc = c & 63;
                const u32x4 v = *(const u32x4*)(a.WR + (size_t)part * 49152 + rr * 1024 + 512 * st + cc * 8);
                *(LAS u32x4*)(lds + part * 36 * RT_PITCH + rr * RT_PITCH + cc * 16) = v; }
            __syncthreads();
#pragma unroll
            for (int i = 0; i < 8; ++i) {
                f32x4 x0, x1; ge::unpack8(xa[i], x0, x1);
                ss += (x0.x * x0.x + x0.y * x0.y) + (x0.z * x0.z + x0.w * x0.w) + (x1.x * x1.x + x1.y * x1.y) + (x1.z * x1.z + x1.w * x1.w);
                const bf16x8 ah = __builtin_bit_cast(bf16x8, xa[i]);
#pragma unroll
                for (int nb = 0; nb < 3; ++nb) { const int off = brow[nb] + (8 * kh + i) * 64;
                    const bf16x8 bh = *(const LAS bf16x8*)(WH + off), bl = *(const LAS bf16x8*)(WL + off);
                    acc[nb] = __builtin_amdgcn_mfma_f32_16x16x32_bf16(ah, bh, acc[nb], 0, 0, 0); acc[nb] = __builtin_amdgcn_mfma_f32_16x16x32_bf16(ah, bl, acc[nb], 0, 0, 0); }
            }
            __syncthreads();
        }
        ss += __shfl_xor(ss, 16); ss += __shfl_xor(ss, 32);
        if (kh == 1) {
#pragma unroll
            for (int nb = 0; nb < 3; ++nb)
#pragma unroll
                for (int r = 0; r < 4; ++r) ex[(blk * 13 + nb * 4 + r) * 64 + lane] = acc[nb][r];
            ex[(blk * 13 + 12) * 64 + lane] = ss; }
        __syncthreads();
        LAS int* lc = (LAS int*)(SS + 64);
        if (tid < 32) lc[tid] = 0;
        int ea = 0, eb = 0, pa = 0, pb = 0; float myr = 0.f, cw0 = 0.f, cw1 = 0.f; const bool sel = (kh == 0) && (lane < 16);
        if (kh == 0) {
#pragma unroll
            for (int nb = 0; nb < 3; ++nb)
#pragma unroll
                for (int r = 0; r < 4; ++r) T[(16 * blk + 4 * kg + r) * 49 + 16 * nb + l15] = acc[nb][r] + ex[(blk * 13 + nb * 4 + r) * 64 + lane];
            if (kg == 0) SS[16 * blk + l15] = ss + ex[(blk * 13 + 12) * 64 + lane];
        }
        __syncthreads();
        if (sel) {
            const int lr = 16 * blk + lane; const LAS float* lp = T + lr * 49; myr = rsqrtf(SS[lr] * (1.0f / 1024.0f) + 1e-6f);
            float gm = lp[0] * myr + a.bg[0]; int gs = 0; float lgv[4]; lgv[0] = gm;
#pragma unroll
            for (int j = 1; j < 4; ++j) { lgv[j] = lp[j] * myr + a.bg[j]; if (lgv[j] > gm) { gm = lgv[j]; gs = j; } }
            float gsum = 0.f;
#pragma unroll
            for (int j = 0; j < 4; ++j) gsum += __expf(lgv[j] - gm);
            const float gpr = 1.0f / gsum;
            float e8[8];
#pragma unroll
            for (int j = 0; j < 8; ++j) e8[j] = lp[4 + gs * 8 + j] * myr + a.br[gs * 8 + j];
            int i0 = 0; float m0 = e8[0];
#pragma unroll
            for (int j = 1; j < 8; ++j) if (e8[j] > m0) { m0 = e8[j]; i0 = j; }
            int i1 = -1; float m1 = -3.0e38f;
#pragma unroll
            for (int j = 0; j < 8; ++j) if (j != i0 && e8[j] > m1) { m1 = e8[j]; i1 = j; }
            const float d = __expf(m1 - m0); cw0 = gpr / (1.0f + d); cw1 = gpr * d / (1.0f + d);
            ea = gs * 8 + i0; eb = gs * 8 + i1;
            pa = __hip_atomic_fetch_add(&lc[ea], 1, __ATOMIC_RELAXED, __HIP_MEMORY_SCOPE_WORKGROUP); pb = __hip_atomic_fetch_add(&lc[eb], 1, __ATOMIC_RELAXED, __HIP_MEMORY_SCOPE_WORKGROUP);
        }
        __syncthreads();
        if (tid < 32) { const int n = lc[tid]; lc[32 + tid] = n > 0 ? atomicAdd(&a.cnt[tid * CNT_STRIDE], n) : 0; }
        __syncthreads();
        if (sel) {
            const int row = grp * 64 + 16 * blk + lane; pa += lc[32 + ea]; pb += lc[32 + eb];
            a.list[ea * 16384 + pa] = row; a.list[eb * 16384 + pb] = row; a.rsl[ea * 16384 + pa] = myr; a.rsl[eb * 16384 + pb] = myr;
            a.RS[row] = myr; a.tok_e[row * 2] = ea; a.tok_e[row * 2 + 1] = eb; a.tok_pos[row * 2] = pa; a.tok_pos[row * 2 + 1] = pb;
            a.tok_w[row * 2] = cw0; a.tok_w[row * 2 + 1] = cw1;
        }
        __syncthreads();
    }
}

__device__ __forceinline__ void combine_phase(bf16_t* XB, bf16_t* XR, float* OUT, const bf16_t* Y, const int* tok_e, const int* tok_pos, const float* tok_w, const LAS int* tpre, const float* gf, bool final_layer, int gw, int NGW, int lane) {
    for (int r8 = gw; r8 < T_ROWS / 8; r8 += NGW) {
        const int row0 = r8 * 8;
        int sl = 0; float wv = 0.f;
        if (lane < 16) { const int e = tok_e[row0 * 2 + lane]; sl = tpre[e] * 256 + tok_pos[row0 * 2 + lane]; wv = tok_w[row0 * 2 + lane]; }
#pragma unroll
        for (int pr = 0; pr < 4; ++pr) {
            u32x2 xv[2][4], ya[2][4], yb[2][4]; float w0[2], w1[2];
#pragma unroll
            for (int q = 0; q < 2; ++q) { const int k = 2 * pr + q;
                const size_t s0 = (size_t)__builtin_amdgcn_readlane(sl, 2 * k), s1 = (size_t)__builtin_amdgcn_readlane(sl, 2 * k + 1);
                w0[q] = __int_as_float(__builtin_amdgcn_readlane(__float_as_int(wv), 2 * k)); w1[q] = __int_as_float(__builtin_amdgcn_readlane(__float_as_int(wv), 2 * k + 1));
                const u32x2* xr = (const u32x2*)(XB + (size_t)(row0 + k) * 1024) + lane; const u32x2* y0 = (const u32x2*)(Y + s0 * 1024) + lane; const u32x2* y1 = (const u32x2*)(Y + s1 * 1024) + lane;
#pragma unroll
                for (int j = 0; j < 4; ++j) { xv[q][j] = xr[64 * j]; ya[q][j] = y0[64 * j]; yb[q][j] = y1[64 * j]; } }
#pragma unroll
            for (int q = 0; q < 2; ++q) { const int row = row0 + 2 * pr + q; float s = 0.f; f32x4 v[4];
#pragma unroll
                for (int j = 0; j < 4; ++j) { const u32x2 x = xv[q][j], a = ya[q][j], b = yb[q][j];
                    v[j].x = blo(x.x) + w0[q] * blo(a.x) + w1[q] * blo(b.x); v[j].y = bhi(x.x) + w0[q] * bhi(a.x) + w1[q] * bhi(b.x); v[j].z = blo(x.y) + w0[q] * blo(a.y) + w1[q] * blo(b.y); v[j].w = bhi(x.y) + w0[q] * bhi(a.y) + w1[q] * bhi(b.y);
                    s += (v[j].x * v[j].x + v[j].y * v[j].y) + (v[j].z * v[j].z + v[j].w * v[j].w); }
                const float rstd = rsqrtf(wave_total(s) * (1.0f / 1024.0f) + 1e-6f);
                if (!final_layer) { u32x2* o = (u32x2*)(XB + (size_t)row * 1024) + lane; u32x2* r = (u32x2*)(XR + (size_t)row * 1024) + lane;
#pragma unroll
                    for (int j = 0; j < 4; ++j) { u32x2 w; w.x = pk2(v[j].x, v[j].y); w.y = pk2(v[j].z, v[j].w); r[64 * j] = w; w.x = pk2(v[j].x * rstd, v[j].y * rstd); w.y = pk2(v[j].z * rstd, v[j].w * rstd); o[64 * j] = w; } }
                else { const f32x4* gr = (const f32x4*)gf + lane; f32x4* xw = (f32x4*)(OUT + (size_t)row * 1024) + lane;
#pragma unroll
                    for (int j = 0; j < 4; ++j) { const f32x4 g = gr[64 * j]; xw[64 * j] = v[j] * rstd * g; } } }
        }
    }
}
}
constexpr int NWAVES = 8;
constexpr int LDS_BYTES = 153600;
constexpr int MISC_OFF = 152576;
constexpr int CW_BAR = 8192;

#define XB_TMO      128
#define XB_XCNT(j)  (256  + 64 * (j))
#define XB_XSUB(j)  (1280 + 64 * (j))
#define XB_XGEN(j)  (2304 + 64 * (j))
#define XB_TOP      3328
#define XB_TOPGEN   3392
#define XCD_BAR_WORDS 3456
#define XB_SPIN_CAP (1u << 18)
__device__ __forceinline__ unsigned xb_ld(unsigned* p)              { return __hip_atomic_load(p, __ATOMIC_RELAXED, __HIP_MEMORY_SCOPE_AGENT); }
__device__ __forceinline__ unsigned xb_add(unsigned* p, unsigned v) { return __hip_atomic_fetch_add(p, v, __ATOMIC_RELAXED, __HIP_MEMORY_SCOPE_AGENT); }
__device__ __forceinline__ unsigned xb_xcc_id() { return (unsigned)__builtin_amdgcn_s_getreg((3 << 11) | 20) & 0xFu; }
#define XB_SPIN(cond, bar) do { unsigned _sp = 0; while (cond) { __builtin_amdgcn_s_sleep(1); \
    if ((++_sp & 255u) == 0u) { if (xb_ld(&(bar)[XB_TMO])) break; if (_sp > XB_SPIN_CAP) { atomicAdd(&(bar)[XB_TMO], 1u); break; } } } } while (0)
struct XcdBarrier { unsigned* bar; unsigned x; volatile LAS unsigned* st; };
__device__ __forceinline__ XcdBarrier xcd_barrier_post(unsigned* bar, volatile LAS unsigned* st) {
    XcdBarrier b; b.bar = bar; b.x = xb_xcc_id(); b.st = st;
    if (threadIdx.x == 0) (void)xb_add(&bar[XB_XCNT(b.x)], 1u);
    return b;
}
__device__ __forceinline__ void xcd_barrier_complete(unsigned* bar, unsigned x, unsigned& nloc, unsigned& nx) {
    const unsigned G = gridDim.x * gridDim.y * gridDim.z;
    unsigned sum, cnt, mine, sp = 0u;
    for (;;) {
        sum = 0u; cnt = 0u; mine = 0u;
#pragma unroll
        for (unsigned j = 0; j < 16; ++j) { const unsigned c = xb_ld(&bar[XB_XCNT(j)]); sum += c; cnt += (c > 0u) ? 1u : 0u; mine = (j == x) ? c : mine; }
        if (sum == G) break;
        __builtin_amdgcn_s_sleep(1);
        if ((++sp & 255u) == 0u) { if (xb_ld(&bar[XB_TMO])) break; if (sp > XB_SPIN_CAP) { atomicAdd(&bar[XB_TMO], 1u); break; } }
    }
    nloc = mine > 0u ? mine : 1u; nx = cnt > 0u ? cnt : 1u;
}
__device__ __forceinline__ void xcd_barrier(const XcdBarrier& b) {
    asm volatile("s_waitcnt vmcnt(0)" ::: "memory");
    __syncthreads();
    if (threadIdx.x == 0) {
        unsigned* bar = b.bar;
        __builtin_amdgcn_s_waitcnt(0);
        unsigned nloc = b.st[0], nx = b.st[1];
        if (nloc == 0u) { xcd_barrier_complete(bar, b.x, nloc, nx); b.st[0] = nloc; b.st[1] = nx; }
        const unsigned old = xb_add(&bar[XB_XSUB(b.x)], 1u);
        const unsigned gen = old / nloc;
        if (old + 1u == (gen + 1u) * nloc) {
            __builtin_amdgcn_fence(__ATOMIC_RELEASE, "agent");
            asm volatile("s_waitcnt vmcnt(0)" ::: "memory");
            const unsigned og = xb_add(&bar[XB_TOP], 1u);
            const unsigned tg = og / nx;
            if (og + 1u == (tg + 1u) * nx) xb_add(&bar[XB_TOPGEN], 1u);
            else XB_SPIN(xb_ld(&bar[XB_TOPGEN]) == tg, bar);
            __builtin_amdgcn_fence(__ATOMIC_ACQUIRE, "agent");
            xb_add(&bar[XB_XGEN(b.x)], 1u);
            asm volatile("s_waitcnt vmcnt(0)" ::: "memory");
        } else {
            XB_SPIN(xb_ld(&bar[XB_XGEN(b.x)]) == gen, bar);
            __builtin_amdgcn_fence(__ATOMIC_ACQUIRE, "agent");
            asm volatile("s_waitcnt vmcnt(0)" ::: "memory");
        }
    }
    __syncthreads();
}

struct Args { const float* in[26]; float* out; unsigned char* ws; int ph_lo, ph_hi, li, pad; };
struct ArgsG { const GAS float* in[26]; GAS float* out; GAS unsigned char* ws; int ph_lo, ph_hi, li, pad; };
static_assert(sizeof(Args) == sizeof(ArgsG), "Args layout");
constexpr int N_PHASES = 18;

__device__ __forceinline__ void build_moe_tab(const int* cnt, volatile LAS int* tp, volatile LAS int* cn, int tid) {
    if (tid < 32) cn[tid] = __hip_atomic_load(cnt + tid * CNT_STRIDE, __ATOMIC_RELAXED, __HIP_MEMORY_SCOPE_AGENT);
    __syncthreads();
    if (tid == 0) { int p = 0; for (int e = 0; e < 32; ++e) { tp[e] = p; p += (cn[e] + 255) >> 8; } tp[32] = p; }
    __syncthreads();
}

__global__ void __launch_bounds__(NWAVES * 64, 2) mega_fwd(Args a_unused) {
    typedef const ArgsG __attribute__((address_space(4)))* KArgs;
#define PIN_KA() KArgs a = (KArgs)__builtin_amdgcn_kernarg_segment_ptr(); asm volatile("" : "+s"(a))
    extern __shared__ __attribute__((aligned(16))) unsigned char lds_raw[];
    LAS unsigned char* lds = (LAS unsigned char*)lds_raw;
    volatile LAS unsigned* MISC = (volatile LAS unsigned*)(lds + MISC_OFF);
    const int tid = threadIdx.x, lane = tid & 63, wave = __builtin_amdgcn_readfirstlane(tid >> 6);
    const int G = gridDim.x, bx = blockIdx.x, vcu = (G % 8 == 0) ? (bx % 8) * (G / 8) + bx / 8 : bx;
    const int gw = vcu * NWAVES + wave, NGW = G * NWAVES;
#ifndef NCONV_CFG
#define NCONV_CFG 96
#define UCONV_CFG 4
#endif
    const int NCONV = (G == 256) ? NCONV_CFG : 0, UCONV = UCONV_CFG;
    unsigned* ctl; int lo, hi;
    { PIN_KA(); ctl = (unsigned*)((unsigned char*)a->ws + WS_CTL) + CW_BAR + a->li * XCD_BAR_WORDS; lo = a->ph_lo; hi = a->ph_hi; }
    for (int u = tid; u < 256; u += NWAVES * 64) MISC[u] = 0u;
    __syncthreads();
    XcdBarrier bar; bar.bar = ctl; bar.x = 0; bar.st = MISC + 8;
    if (hi - lo > 1) bar = xcd_barrier_post(ctl, MISC + 8);
#ifdef ONLY_PHASE
#define RUN(k) ((((k) < 2 ? (k) : 2 + ((k) - 2) % 8) == ONLY_PHASE) && lo <= (k) && (k) < hi)
#else
#define RUN(k) (lo <= (k) && (k) < hi)
#endif
#define PIN_TID() int ptid = threadIdx.x; asm volatile("" : "+v"(ptid)); const int plane = ptid & 63
#ifndef REPEAT_PHASE
#define REPEAT_PHASE (-1)
#endif
#define NREP(k) (((((k) < 2 ? (k) : 2 + ((k) - 2) % 8) == REPEAT_PHASE) ? 2 : 1))
#ifdef DOUBLE_SEAM
#define SEAM(k) do { if (RUN(k) && RUN((k) + 1)) { xcd_barrier(bar); xcd_barrier(bar); } } while (0)
#else
#define SEAM(k) do { if (RUN(k) && RUN((k) + 1)) xcd_barrier(bar); } while (0)
#endif
    volatile LAS int* tpre = (volatile LAS int*)(lds + MISC_OFF + 256); volatile LAS int* tcn = (volatile LAS int*)(lds + MISC_OFF + 512);
#define PIN_WS() PIN_KA(); GAS unsigned char* wsg = a->ws; asm volatile("" : "+s"(wsg)); unsigned char* ws = (unsigned char*)wsg
#define BUF(T, off) ((T*)(ws + (off)))

    for (int rep_ = 0; rep_ < NREP(0); ++rep_) if (RUN(0)) { PIN_WS();
        { PIN_TID(); tp::p0_prologue(a->in, ws, gw, NGW, plane, NCONV > 0); }
    }
    SEAM(0);
    for (int l = 0; l < NLAYER; ++l) {
        const int pb = 2 + 8 * l;
        if (l == 0 && NCONV > 0 && RUN(pb + 0) && bx >= G - NCONV) { PIN_WS();
            { PIN_TID(); tp::p0_items<2>(a->in, ws, (bx - (G - NCONV)) * NWAVES + wave, NCONV * NWAVES, plane); }
            __syncthreads(); }
        for (int rep_ = 0; rep_ < NREP(pb + 0); ++rep_) if (RUN(pb + 0)) { PIN_WS(); gp::PhGemm1 ph; ph.XB = BUF(const char, WS_XB); ph.WT = BUF(const char, W_IN + (size_t)l * 18 * MiB); ph.rs = BUF(float, WS_RT + RT_RS); ph.bglu = (const float*)a->in[8] + l * 2048; ph.bgate = (const float*)a->in[5] + l * 3072;
            ph.CV = BUF(bf16_t, WS_CV); ph.GB = BUF(bf16_t, WS_GB); ph.U = BUF(bf16_t, WS_U); ph.Q = BUF(bf16_t, WS_Q); ph.G = BUF(bf16_t, WS_G); ph.Gd = G; ph.c = bx; ph.only = a->pad; ph.nconv = (l == 0) ? NCONV : 0; ph.ucv = UCONV; ge::gemm_phase(lds, ph); }
        if (l == 0) { for (int rep_ = 0; rep_ < NREP(1); ++rep_) if (RUN(1)) { PIN_WS(); gp::PhKV ph; ph.MEMN = BUF(const char, WS_MEMN); ph.WT = BUF(const char, W_KV); ph.KV = BUF(bf16_t, WS_KV); ph.Gd = G; ph.c = bx; ph.nconv = NCONV; ge::gemm_phase(lds, ph); } }
        SEAM(pb + 0);
        for (int rep_ = 0; rep_ < NREP(pb + 1); ++rep_) if (RUN(pb + 1)) {
#ifndef P2REP
#define P2REP (-1)
#endif
#define P2RUN(x) (rep_ == NREP(pb + 1) - 1 || (x) == P2REP)
#if !defined(P2SEL) || P2SEL == 0
            if (P2RUN(0)) { PIN_WS(); PIN_TID(); (void)plane; tp::attn_phase(BUF(bf16_t, WS_Q), BUF(bf16_t, WS_KV) + (size_t)l * 1024 * 2048, BUF(bf16_t, WS_O), lds, vcu, G, ptid); }
            asm volatile("" ::: "memory"); __builtin_amdgcn_sched_barrier(0);
#endif
#if !defined(P2SEL) || P2SEL == 1
            if (P2RUN(1)) { PIN_WS(); PIN_TID(); (void)plane; tp::bconv_phase(BUF(bf16_t, WS_U), (const float*)a->in[9] + l * 31 * 1024, (const float*)a->in[10] + l * 1024, (const float*)a->in[11] + l * 1024, (const float*)a->in[12] + l * 1024, BUF(bf16_t, WS_UB), lds, vcu, G, ptid); }
            asm volatile("" ::: "memory"); __builtin_amdgcn_sched_barrier(0);
#endif
#if !defined(P2SEL) || P2SEL == 2
            if (P2RUN(2)) { PIN_WS(); PIN_TID(); (void)plane; tp::aconv_phase(BUF(bf16_t, WS_CV), BUF(bf16_t, WS_GB), (const float*)a->in[6] + l * 3 * 1024, BUF(bf16_t, WS_AC), vcu, G, ptid); }
#endif
        }
        SEAM(pb + 1);
        for (int rep_ = 0; rep_ < NREP(pb + 2); ++rep_) if (RUN(pb + 2)) { PIN_WS();
            static_assert(WS_UB - WS_AC == 32 * MiB && WS_O - WS_UB == 32 * MiB && W_OB - W_OA == 4 * MiB && W_OX - W_OB == 4 * MiB, "PhOut3 strides");
            gp::PhOut3 ph; ph.AC = BUF(const char, WS_AC); ph.WA = BUF(const char, W_OA + (size_t)l * 2 * MiB); ph.bb = (const float*)a->in[14] + l * 1024; ph.G = BUF(bf16_t, WS_G); ph.MG = BUF(bf16_t, WS_MG); ph.pcnt = BUF(unsigned, WS_CTL) + CW_PCNT + l * PCNT_LAYER; ph.Gd = G; ph.c = bx; ge::gemm_phase(lds, ph); }
#ifdef MIX_SEAMS
        SEAM(pb + 2);
#endif
        for (int rep_ = 0; rep_ < NREP(pb + 3); ++rep_) if (RUN(pb + 3)) { PIN_WS(); gp::PhWo ph; ph.MG = BUF(const char, WS_MG); ph.WT = BUF(const char, W_O + (size_t)l * 2 * MiB); ph.xin_f = (l == 0) ? (const float*)a->in[0] : nullptr; ph.xin_b = BUF(bf16_t, WS_XR); ph.XBo = BUF(bf16_t, WS_XB); ph.pin = BUF(unsigned, WS_CTL) + CW_PCNT + l * PCNT_LAYER; ph.pout = ph.pin + 4096; ph.tmo = BUF(unsigned, WS_CTL) + CW_TMO; ph.Gd = G; ph.c = bx; ge::gemm_phase(lds, ph); }
#ifdef MIX_SEAMS
        SEAM(pb + 3);
#endif
        for (int rep_ = 0; rep_ < NREP(pb + 4); ++rep_) if (RUN(pb + 4)) { PIN_WS(); tp::RouteArgs r; r.pcnt = BUF(unsigned, WS_CTL) + CW_PCNT + l * PCNT_LAYER + 4096; r.tmo = BUF(unsigned, WS_CTL) + CW_TMO; r.X = BUF(bf16_t, WS_XB); r.WR = BUF(bf16_t, W_RT) + (size_t)l * 98304; r.bg = (const float*)a->in[20] + l * 4; r.br = (const float*)a->in[22] + l * 32; r.RS = BUF(float, WS_RT + RT_RS);
            r.tok_e = BUF(int, WS_RT + RT_TOKE); r.tok_pos = BUF(int, WS_RT + RT_TOKP); r.tok_w = BUF(float, WS_RT + RT_TOKW);
            r.cnt = BUF(int, WS_CTL) + CW_CNT + l * CNT_LAYER; r.list = BUF(int, WS_RT + RT_LIST); r.rsl = BUF(float, WS_RSL);
            if (NREP(pb + 4) == 2 && rep_ == 0) { r.RS = BUF(float, WS_F32A); r.tok_e = BUF(int, WS_F32A + 1 * MiB); r.tok_pos = BUF(int, WS_F32A + 2 * MiB); r.tok_w = BUF(float, WS_F32A + 3 * MiB); r.cnt = BUF(int, WS_CTL) + CW_CNT + 2 * CNT_LAYER + l * CNT_LAYER; r.list = BUF(int, WS_F32A + 4 * MiB); r.rsl = BUF(float, WS_F32A + 8 * MiB); } { PIN_TID(); (void)plane; tp::route_phase(r, lds, vcu, G, ptid); } }
        SEAM(pb + 4);
        for (int rep_ = 0; rep_ < NREP(pb + 5); ++rep_) if (RUN(pb + 5)) { PIN_WS(); build_moe_tab(BUF(int, WS_CTL) + CW_CNT + l * CNT_LAYER, tpre, tcn, tid);
            gp::PhMoeGU ph; ph.XB = BUF(const char, WS_XB); ph.WT = BUF(const char, W_GU + (size_t)l * 64 * MiB); ph.list = BUF(int, WS_RT + RT_LIST); ph.rsl = BUF(float, WS_RSL); ph.HID = BUF(bf16_t, WS_HID);
            ph.tcnt = BUF(unsigned, WS_CTL) + CW_TCNT + l * TCNT_LAYER; ph.tb.tp = (const LAS int*)tpre; ph.tb.cn = (const LAS int*)tcn; ph.Gd = G; ph.c = vcu; ge::gemm_phase(lds, ph); }
#ifdef MOE_SEAM
        SEAM(pb + 5);
#endif
        for (int rep_ = 0; rep_ < NREP(pb + 6); ++rep_) if (RUN(pb + 6)) { PIN_WS(); build_moe_tab(BUF(int, WS_CTL) + CW_CNT + l * CNT_LAYER, tpre, tcn, tid);
            gp::PhMoeDn ph; ph.HID = BUF(const char, WS_HID); ph.WT = BUF(const char, W_DN + (size_t)l * 32 * MiB); ph.Y = BUF(bf16_t, WS_Y); ph.tcnt = BUF(unsigned, WS_CTL) + CW_TCNT + l * TCNT_LAYER; ph.tmo = BUF(unsigned, WS_CTL) + CW_TMO; ph.tb.tp = (const LAS int*)tpre; ph.tb.cn = (const LAS int*)tcn; ph.Gd = G; ph.c = vcu;
            ge::gemm_phase(lds, ph); }
        SEAM(pb + 6);
        for (int rep_ = 0; rep_ < NREP(pb + 7); ++rep_) if (RUN(pb + 7)) { PIN_WS(); build_moe_tab(BUF(int, WS_CTL) + CW_CNT + l * CNT_LAYER, tpre, tcn, tid);
            { PIN_TID(); tp::combine_phase(BUF(bf16_t, WS_XB), BUF(bf16_t, WS_XR), (float*)a->out, BUF(bf16_t, WS_Y), BUF(int, WS_RT + RT_TOKE), BUF(int, WS_RT + RT_TOKP), BUF(float, WS_RT + RT_TOKW), (const LAS int*)tpre, (const float*)a->in[25], l == NLAYER - 1, gw, NGW, plane); } }
        SEAM(pb + 7);
    }
#undef RUN
#undef SEAM
}

static int g_grid = 0;
static bool mega_setup() {
    if (g_grid) return g_grid > 0;
    int dev = 0, cus = 0;
    if (hipGetDevice(&dev) != hipSuccess || hipDeviceGetAttribute(&cus, hipDeviceAttributeMultiprocessorCount, dev) != hipSuccess) { g_grid = -1; return false; }
    if (hipFuncSetAttribute((const void*)mega_fwd, hipFuncAttributeMaxDynamicSharedMemorySize, LDS_BYTES) != hipSuccess) { fprintf(stderr, "mega: hipFuncSetAttribute failed\n"); g_grid = -1; return false; }
    int per_cu = 0;
    if (hipOccupancyMaxActiveBlocksPerMultiprocessor(&per_cu, (const void*)mega_fwd, NWAVES * 64, LDS_BYTES) != hipSuccess || per_cu < 1) { fprintf(stderr, "mega: occupancy query says %d blocks/CU\n", per_cu); (void)hipGetLastError(); }
    g_grid = cus;
    return true;
}
static void mega_launch(void* const* d_in, void* d_out, void* d_ws, int lo, int hi, int li, hipStream_t stream, int only = 0) {
    if (!mega_setup()) return;
    Args a{};
    for (int i = 0; i < 26; ++i) a.in[i] = (const float*)d_in[i];
    a.out = (float*)d_out; a.ws = (unsigned char*)d_ws; a.ph_lo = lo; a.ph_hi = hi; a.li = li; a.pad = only;
    hipLaunchKernelGGL(mega_fwd, dim3(g_grid), dim3(NWAVES * 64), LDS_BYTES, stream, a);
}
extern "C" void kernel_launch(void* const* d_in, const int* in_sizes, int n_in, void* d_out, int out_size, void* d_ws, size_t ws_size, hipStream_t stream) {
    if (n_in != 26 || out_size != T_ROWS * DM || ws_size < WS_END) { fprintf(stderr, "kernel_launch: unexpected shapes/ws (%d inputs, out %d, ws %zu)\n", n_in, out_size, ws_size); return; }
    (void)hipMemsetAsync((char*)d_ws + WS_CTL, 0, CTL_BYTES, stream);
    mega_launch(d_in, d_out, d_ws, 0, N_PHASES, 0, stream);
}
```

```cpp
#include <hip/hip_runtime.h>
#include <cstdio>
#include <cstdint>
typedef unsigned short bf16_t;
__device__ __forceinline__ float bf2f(bf16_t b) { return __uint_as_float(((unsigned)b) << 16); }
__device__ __forceinline__ bf16_t f2bf(float f) { unsigned u = __float_as_uint(f); return (bf16_t)((u + 0x7fffu + ((u >> 16) & 1u)) >> 16); }

constexpr int T_ROWS = 16384, DM = 1024, SEQ = 4096, NB = 4, MEMLEN = 256, NLAYER = 2, NIN = 9216, NEXP = 32, DFF = 512;
constexpr int SLOTS_MAX = 40960;
constexpr size_t MiB = (size_t)1 << 20;
constexpr size_t WS_CTL = 0, CTL_BYTES = 1 * MiB;
constexpr size_t WS_W = 1 * MiB;
constexpr size_t W_IN = 1 * MiB, W_OA = 37 * MiB, W_OB = 41 * MiB, W_OX = 45 * MiB, W_O = 49 * MiB, W_KV = 53 * MiB, W_GU = 61 * MiB, W_DN = 189 * MiB, W_RT = 253 * MiB;
#define GAS __attribute__((address_space(1)))
constexpr size_t WS_XB = 272 * MiB, WS_CV = 304 * MiB, WS_GB = 336 * MiB, WS_U = 368 * MiB, WS_Q = 400 * MiB, WS_G = 432 * MiB;
constexpr size_t WS_AC = 528 * MiB, WS_UB = 560 * MiB, WS_O = 592 * MiB, WS_MG = 624 * MiB;
constexpr size_t WS_KV = 656 * MiB, WS_MEMN = 664 * MiB, WS_RT = 668 * MiB;
constexpr size_t RT_RS = 0, RT_TOKE = 64 * 1024, RT_TOKP = 192 * 1024, RT_TOKW = 320 * 1024, RT_BASE = 448 * 1024, RT_LIST = 1 * MiB;
constexpr size_t WS_XR = 920 * MiB;
constexpr size_t WS_HID = 672 * MiB, WS_Y = 712 * MiB, WS_F32A = 792 * MiB, WS_RSL = 984 * MiB, WS_END = 986 * MiB;
constexpr int CW_TMO = 16, CW_TCNT = 131072, TCNT_LAYER = 16384;
constexpr int CW_PCNT = 163840, PCNT_LAYER = 8192;
constexpr int CW_CNT = 1024, CNT_STRIDE = 64, CNT_LAYER = 2048;

namespace ge {
#define LAS __attribute__((address_space(3)))
typedef short bf16x8 __attribute__((ext_vector_type(8)));
typedef float f32x4 __attribute__((ext_vector_type(4)));
typedef unsigned u32x4 __attribute__((ext_vector_type(4)));
constexpr int BM = 256, BK = 64, HALF = 128, HTB = HALF * BK * 2, STAGE_BYTES = 8 * HTB, NXCD = 8, WGM = 8;

__host__ __device__ __forceinline__ int lds_byte(int r, int c) { const int st = (r >> 4) * 2 + (c >> 5), rr = r & 15, cc = c & 31, ob = rr * 64 + cc * 2; return st * 1024 + (ob ^ (((ob >> 9) & 1) << 5)); }
__host__ __device__ __forceinline__ void stage_rc(int b, int& R, int& C) { const int st = b / 1024, sb = b % 1024, swz = sb ^ (((sb >> 9) & 1) << 5); R = (st >> 1) * 16 + swz / 64; C = (st & 1) * 32 + (swz % 64) / 2; }
__host__ __device__ __forceinline__ int perm32(int rho) { const int n = rho >> 4, i = rho & 15; return 8 * (i >> 2) + 4 * n + (i & 3); }

typedef float f32x2_cv __attribute__((ext_vector_type(2)));
typedef __bf16 bf16x2_cv __attribute__((ext_vector_type(2)));
__device__ __forceinline__ unsigned cvt_pk_bf16(float lo, float hi) { const f32x2_cv v = {lo, hi}; const bf16x2_cv b = __builtin_convertvector(v, bf16x2_cv); return __builtin_bit_cast(unsigned, b); }
__device__ __forceinline__ u32x4 pack8(const f32x4 a, const f32x4 b) { u32x4 w; w.x = cvt_pk_bf16(a[0], a[1]); w.y = cvt_pk_bf16(a[2], a[3]); w.z = cvt_pk_bf16(b[0], b[1]); w.w = cvt_pk_bf16(b[2], b[3]); return w; }
__device__ __forceinline__ float fsigm(float x) { return __builtin_amdgcn_rcpf(1.0f + __builtin_amdgcn_exp2f(-1.44269504f * x)); }
__device__ __forceinline__ f32x4 sigm4(const f32x4 x) { f32x4 r; r[0] = fsigm(x[0]); r[1] = fsigm(x[1]); r[2] = fsigm(x[2]); r[3] = fsigm(x[3]); return r; }
__device__ __forceinline__ void unpack8(const u32x4 w, f32x4& a, f32x4& b) {
    a[0] = __uint_as_float(w.x << 16); a[1] = __uint_as_float(w.x & 0xffff0000u); a[2] = __uint_as_float(w.y << 16); a[3] = __uint_as_float(w.y & 0xffff0000u);
    b[0] = __uint_as_float(w.z << 16); b[1] = __uint_as_float(w.z & 0xffff0000u); b[2] = __uint_as_float(w.w << 16); b[3] = __uint_as_float(w.w & 0xffff0000u); }

__device__ __forceinline__ void st16_wt(void* ubase, unsigned loff, const u32x4 v) { asm volatile("s_nop 4\n\tglobal_store_dwordx4 %0, %1, %2 sc1\n\ts_nop 1" :: "v"(loff), "v"(v), "s"(ubase) : "memory"); }
__device__ __forceinline__ void st16_wt(void* ubase, unsigned loff, const f32x4 v) { asm volatile("s_nop 4\n\tglobal_store_dwordx4 %0, %1, %2 sc1\n\ts_nop 1" :: "v"(loff), "v"(v), "s"(ubase) : "memory"); }
__device__ __forceinline__ void st16_buf(void* ubase, unsigned loff, const u32x4 v) {
    const __amdgpu_buffer_rsrc_t r = __builtin_amdgcn_make_buffer_rsrc(ubase, 0, 0x7fffffff, 0x00020000);
    __builtin_amdgcn_raw_buffer_store_b128(v, r, loff, 0, 16); }
__device__ __forceinline__ int xcd_remap(int L, int nwg) { const int q = nwg / NXCD, r = nwg % NXCD, xcd = L % NXCD, off = L / NXCD; return (xcd < r ? xcd * (q + 1) : r * (q + 1) + (xcd - r) * q) + off; }
__device__ __forceinline__ void tile_order(int L, int nM, int nN, int& pm, int& pn) {
    const int wgid = xcd_remap(L, nM * nN);
    const int nig = WGM * nN, gid = wgid / nig, fm = gid * WGM, gsz = (nM - fm) < WGM ? (nM - fm) : WGM;
    pm = fm + ((wgid % nig) % gsz); pn = (wgid % nig) / gsz;
}

struct Unit { int pm, pn, sub, aux; };

template <class P>
__device__ __forceinline__ void gemm_phase(LAS unsigned char* lds, const P& ph) {
    int tid = threadIdx.x; asm volatile("" : "+v"(tid));
    const int wid = __builtin_amdgcn_readfirstlane(tid >> 6), lane = tid & 63, wr = wid >> 2, wc = wid & 3, fr = lane & 15, fq = lane >> 4;
    constexpr int nt = P::NT;
    unsigned voffA[2], voffB[2];
#pragma unroll
    for (int i = 0; i < 2; ++i) { int R, C; stage_rc(tid * 16 + i * 8192, R, C); const int Rb = (R & ~31) + perm32(R & 31); voffA[i] = (unsigned)(R * P::LDA + C) * 2u; voffB[i] = (unsigned)(Rb * P::KB + C) * 2u; }
    constexpr size_t hstepA = P::GATHER ? 0 : (size_t)HALF * P::LDA * 2;
    const size_t kstep = (size_t)(BK * 2);
    const unsigned ldsw = (unsigned)wid * 1024u;
    const int aoff = lds_byte(wr * 64 + fr, fq * 8), boff = lds_byte(wc * 32 + fr, fq * 8);
#define GE_SA(b, h) (((b) * 2 + (h)) * HTB)
#define GE_SB(b, h) ((4 + (b) * 2 + (h)) * HTB)
#define GE_STAGE(bufoff, gbase, voff) do { _Pragma("unroll") for (int _i = 0; _i < 2; ++_i) \
        __builtin_amdgcn_global_load_lds((const unsigned*)((const char*)(gbase) + (voff)[_i]), (LAS unsigned*)(lds + (bufoff) + ldsw + _i * 8192), 16, 0, 0); } while (0)
#define GE_LDA(dst, b, h) do { _Pragma("unroll") for (int m = 0; m < 4; ++m) _Pragma("unroll") for (int k = 0; k < 2; ++k) dst[m][k] = *(const LAS bf16x8*)(lds + GE_SA(b, h) + aoff + m * 2048 + k * 1024); } while (0)
#define GE_LDB(dst, b, h) do { _Pragma("unroll") for (int n = 0; n < 2; ++n) _Pragma("unroll") for (int k = 0; k < 2; ++k) dst[n][k] = *(const LAS bf16x8*)(lds + GE_SB(b, h) + boff + n * 2048 + k * 1024); } while (0)
#define GE_MMA(ai, bj, At, Bt) do { __builtin_amdgcn_s_setprio(1); _Pragma("unroll") for (int m = 0; m < 4; ++m) _Pragma("unroll") for (int n = 0; n < 2; ++n) _Pragma("unroll") for (int k = 0; k < 2; ++k) \
        acc[ai][bj][m][n] = __builtin_amdgcn_mfma_f32_16x16x32_bf16(Bt[n][k], At[m][k], acc[ai][bj][m][n], 0, 0, 0); __builtin_amdgcn_s_setprio(0); } while (0)
#define GE_WAIT_V(n) asm volatile("s_waitcnt vmcnt(" #n ")" ::: "memory")
#define GE_WAIT_L(n) asm volatile("s_waitcnt lgkmcnt(" #n ")" ::: "memory")
#define GE_BAR __builtin_amdgcn_s_barrier()
#define GE_SCHED __builtin_amdgcn_sched_barrier(0)
    Unit cur, nxt; int ui = 0;
    if (!ph.next(0, cur)) return;
    f32x4 acc[2][2][4][2];
#pragma unroll
    for (int a = 0; a < 2; ++a)
#pragma unroll
        for (int b = 0; b < 2; ++b)
#pragma unroll
            for (int m = 0; m < 4; ++m)
#pragma unroll
                for (int n = 0; n < 2; ++n) acc[a][b][m][n] = (f32x4){0.f, 0.f, 0.f, 0.f};
    bf16x8 At[4][2], B0[2][2], B1[2][2];
    unsigned cao[2][2], nao[2][2];
    if constexpr (P::GATHER) ph.a_offs(cur, tid, cao);
#define GE_STAGE_A(bufoff, gbase, h, offs) do { if constexpr (P::GATHER) { GE_STAGE(bufoff, gbase, (offs)[h]); } else { GE_STAGE(bufoff, (gbase) + (h) * hstepA, voffA); } } while (0)
    const char* cA = ph.a_base(cur); const char* cB0 = ph.b_base(cur, 0); const char* cB1 = ph.b_base(cur, 1);
    ph.a_ready(cur);
    GE_STAGE(GE_SB(0, 0), cB0, voffB); GE_STAGE(GE_SB(0, 1), cB1, voffB); GE_STAGE_A(GE_SA(0, 0), cA, 0, cao); GE_STAGE_A(GE_SA(0, 1), cA, 1, cao);
    if (wr == 1) GE_BAR;
    GE_WAIT_V(2); GE_BAR;
    GE_STAGE(GE_SB(1, 0), cB0 + kstep, voffB); GE_STAGE_A(GE_SA(1, 0), cA + kstep, 0, cao); GE_STAGE(GE_SB(1, 1), cB1 + kstep, voffB);
    GE_WAIT_V(6); GE_BAR;
    for (;;) {
        const bool has_next = ph.next(ui + 1, nxt);
        const char* nA = cA; const char* nB0 = cB0; const char* nB1 = cB1;
        if constexpr (P::GATHER) {
#pragma unroll
            for (int h = 0; h < 2; ++h)
#pragma unroll
                for (int i = 0; i < 2; ++i) nao[h][i] = cao[h][i]; }
        if (has_next) { nA = ph.a_base(nxt); nB0 = ph.b_base(nxt, 0); nB1 = ph.b_base(nxt, 1); if constexpr (P::GATHER) ph.a_offs(nxt, tid, nao); }
        for (int t = 0; t < nt; t += 2) {
            const bool last = (t == nt - 2);
            if (last && has_next) ph.a_ready(nxt);
            const char* a1 = cA + (size_t)(t + 1) * kstep;
            const char* a2 = last ? nA : cA + (size_t)(t + 2) * kstep;
            const char* b20 = last ? nB0 : cB0 + (size_t)(t + 2) * kstep; const char* b21 = last ? nB1 : cB1 + (size_t)(t + 2) * kstep;
            const char* a3 = a2 + kstep; const char* b30 = b20 + kstep; const char* b31 = b21 + kstep;
            unsigned ao2[2][2];
            if constexpr (P::GATHER) {
#pragma unroll
                for (int h = 0; h < 2; ++h)
#pragma unroll
                    for (int i = 0; i < 2; ++i) ao2[h][i] = last ? nao[h][i] : cao[h][i]; }
            GE_LDB(B0, 0, 0); GE_LDB(B1, 0, 1); GE_SCHED; GE_LDA(At, 0, 0); GE_STAGE_A(GE_SA(1, 1), a1, 1, cao);
            GE_WAIT_V(8); GE_WAIT_L(0); GE_BAR; GE_MMA(0, 0, At, B0); GE_MMA(0, 1, At, B1); GE_BAR; GE_SCHED;
            GE_LDA(At, 0, 1); GE_STAGE(GE_SB(0, 0), b20, voffB); GE_STAGE(GE_SB(0, 1), b21, voffB); GE_STAGE_A(GE_SA(0, 0), a2, 0, ao2);
            GE_WAIT_V(8); GE_WAIT_L(0); GE_BAR; GE_MMA(1, 0, At, B0); GE_MMA(1, 1, At, B1); GE_BAR; GE_SCHED;
            GE_LDB(B0, 1, 0); GE_LDB(B1, 1, 1); GE_SCHED; GE_LDA(At, 1, 0); GE_STAGE_A(GE_SA(0, 1), a2, 1, ao2);
            GE_WAIT_V(8); GE_WAIT_L(0); GE_BAR; GE_MMA(0, 0, At, B0); GE_MMA(0, 1, At, B1); GE_BAR; GE_SCHED;
            GE_LDA(At, 1, 1); GE_STAGE(GE_SB(1, 0), b30, voffB); GE_STAGE(GE_SB(1, 1), b31, voffB); GE_STAGE_A(GE_SA(1, 0), a3, 0, ao2);
            GE_WAIT_V(8); GE_WAIT_L(0); GE_BAR; GE_MMA(1, 0, At, B0); GE_MMA(1, 1, At, B1); GE_BAR; GE_SCHED;
        }
        if (wr == 0) GE_BAR;
        ph.epilogue(acc, cur, wr, wc, fr, fq);
#ifdef EPI_TWICE
        if constexpr (P::NT == 16 && P::KB == 1024 && !P::GATHER && sizeof(P) > 90) ph.epilogue(acc, cur, wr, wc, fr, fq);
#endif
        ph.done(cur);
        if (!has_next) break;
        if (!ph.keep_acc(cur)) {
#pragma unroll
            for (int a = 0; a < 2; ++a)
#pragma unroll
                for (int b = 0; b < 2; ++b)
#pragma unroll
                    for (int m = 0; m < 4; ++m)
#pragma unroll
                        for (int n = 0; n < 2; ++n) acc[a][b][m][n] = (f32x4){0.f, 0.f, 0.f, 0.f};
        }
        cur = nxt; cA = nA; cB0 = nB0; cB1 = nB1; ++ui;
        if constexpr (P::GATHER) {
#pragma unroll
            for (int h = 0; h < 2; ++h)
#pragma unroll
                for (int i = 0; i < 2; ++i) cao[h][i] = nao[h][i]; }
        if (wr == 1) GE_BAR;
    }
    GE_WAIT_V(0);
    GE_BAR;
#undef GE_SA
#undef GE_SB
#undef GE_STAGE
#undef GE_STAGE_A
#undef GE_LDA
#undef GE_LDB
#undef GE_MMA
#undef GE_WAIT_V
#undef GE_WAIT_L
#undef GE_BAR
#undef GE_SCHED
}
}
namespace gp {
using namespace ge;
typedef const char* cptr;
#define GP_ROW(ai, m) (128 * (ai) + 64 * wr + 16 * (m) + fr)
#define GP_COL(bj) (128 * (bj) + 32 * wc + 8 * fq)
__device__ __forceinline__ void ld8f(const float* p, f32x4& a, f32x4& b) { a = *(const f32x4*)p; b = *(const f32x4*)(p + 4); }
__device__ __forceinline__ void st8b(bf16_t* p, const f32x4 a, const f32x4 b) { *(u32x4*)p = pack8(a, b); }

#define GP_LD16(ubase, loff) (*(const u32x4*)((const char*)(ubase) + (loff)))
#ifdef BUF_STORES
#define GP_ST16(ubase, loff, val) st16_buf((void*)(ubase), (loff), (val))
#elif !defined(WT_STORES)
#define GP_ST16(ubase, loff, val) (*(u32x4*)((char*)(ubase) + (loff)) = (val))
#else
#define GP_ST16(ubase, loff, val) st16_wt((void*)(ubase), (loff), (val))
#endif
#define GP_FENCE() asm volatile("" ::: "memory")

constexpr unsigned HOOK_SPIN_CAP = 1u << 20;
__device__ __forceinline__ void hook_publish(unsigned* cnt) {
    asm volatile("s_waitcnt vmcnt(0)" ::: "memory");
    if ((threadIdx.x & 63) == 0) __hip_atomic_fetch_add(cnt, 1u, __ATOMIC_RELAXED, __HIP_MEMORY_SCOPE_AGENT);
}
__device__ __forceinline__ void hook_wait(unsigned* cnt, unsigned need, unsigned* tmo) {
    if (threadIdx.x < 64) {
        unsigned spins = 0;
        while ((unsigned)__builtin_amdgcn_readfirstlane(__hip_atomic_load(cnt, __ATOMIC_RELAXED, __HIP_MEMORY_SCOPE_AGENT)) < need) {
            if ((++spins & 255u) == 0u && (__builtin_amdgcn_readfirstlane(__hip_atomic_load(tmo, __ATOMIC_RELAXED, __HIP_MEMORY_SCOPE_AGENT)) != 0u || spins > HOOK_SPIN_CAP)) { if (threadIdx.x == 0) __hip_atomic_store(tmo, 1u, __ATOMIC_RELAXED, __HIP_MEMORY_SCOPE_AGENT); break; }
            __builtin_amdgcn_s_sleep(2); }
        __builtin_amdgcn_fence(__ATOMIC_ACQUIRE, "agent");
        asm volatile("s_waitcnt vmcnt(0)" ::: "memory");
    }
    asm volatile("" ::: "memory"); __builtin_amdgcn_s_barrier(); asm volatile("" ::: "memory");
}
struct PhGemm1 {
    static constexpr int NT = 16, KB = 1024, LDA = 1024; static constexpr bool GATHER = false;
    cptr XB, WT; const float *rs, *bglu, *bgate; bf16_t *CV, *GB, *U, *Q, *G; int Gd, c, only, nconv, ucv;
    __device__ __forceinline__ bool next(int i, Unit& u) const { if (only > 0) { if (i > 0) return false; i = only - 1; }
        int L;
        if (nconv > 0) { const int ng = Gd - nconv, ncu = ucv * nconv, ngu = 64 * 36 - ncu;
            if (c < ng) { L = i * ng + c; if (L >= ngu) return false; } else { if (i >= ucv) return false; L = ngu + i * nconv + (c - ng); } }
        else L = i * Gd + c;
        if (L >= 64 * 36) return false; tile_order(L, 64, 36, u.pm, u.pn); u.sub = 0; u.aux = 0; return true; }
    __device__ __forceinline__ cptr a_base(const Unit& u) const { return XB + (size_t)u.pm * 256 * 2048; }
    __device__ __forceinline__ cptr b_base(const Unit& u, int half) const {
        const int pn = u.pn; int row;
        if (pn < 8) row = half ? 2048 + 128 * pn : 128 * pn;
        else if (pn < 12) row = 1024 + 256 * (pn - 8) + 128 * half;
        else if (pn < 20) row = (half ? 4096 : 3072) + 128 * (pn - 12);
        else if (pn < 24) row = 5120 + 256 * (pn - 20) + 128 * half;
        else row = 6144 + 256 * (pn - 24) + 128 * half;
        return WT + (size_t)row * 2048;
    }
    __device__ __forceinline__ bool keep_acc(const Unit&) const { return false; }
    __device__ __forceinline__ void a_ready(const Unit&) const {}
    __device__ __forceinline__ void done(const Unit&) const {}
    __device__ __forceinline__ void epilogue(f32x4 (&acc)[2][2][4][2], const Unit& u, int wr, int wc, int fr, int fq) const {
        const int pn = u.pn; const size_t row0 = (size_t)u.pm * 256 + 64 * wr;
        const unsigned lo = (unsigned)(fr * 1024 + 32 * wc + 8 * fq) * 2u;
        if (pn < 8) {
            bf16_t* ob = CV + row0 * 1024 + 128 * pn;
#pragma unroll
            for (int ai = 0; ai < 2; ++ai)
#pragma unroll
                for (int m = 0; m < 4; ++m) {
                    GP_ST16(ob + (size_t)(128 * ai + 16 * m) * 1024, lo, pack8(acc[ai][0][m][0] * acc[ai][1][m][0], acc[ai][0][m][1] * acc[ai][1][m][1])); GP_FENCE(); }
        } else if (pn < 12 || (pn >= 20 && pn < 24)) {
            bf16_t* ob = (pn < 12 ? GB + 256 * (pn - 8) : Q + 256 * (pn - 20)) + row0 * 1024;
#pragma unroll
            for (int ai = 0; ai < 2; ++ai)
#pragma unroll
                for (int m = 0; m < 4; ++m) {
#pragma unroll
                    for (int bj = 0; bj < 2; ++bj) GP_ST16(ob + (size_t)(128 * ai + 16 * m) * 1024 + 128 * bj, lo, pack8(acc[ai][bj][m][0], acc[ai][bj][m][1]));
                    GP_FENCE(); }
        } else if (pn < 20) {
            const int c0 = 128 * (pn - 12); bf16_t* ob = U + row0 * 1024 + c0; const unsigned bo = (unsigned)(32 * wc + 8 * fq) * 4u;
            const f32x4 bv0 = *(const f32x4*)((const char*)(bglu + c0) + bo), bv1 = *(const f32x4*)((const char*)(bglu + c0 + 4) + bo);
            const f32x4 bg0 = *(const f32x4*)((const char*)(bglu + 1024 + c0) + bo), bg1 = *(const f32x4*)((const char*)(bglu + 1028 + c0) + bo);
#pragma unroll
            for (int ai = 0; ai < 2; ++ai)
#pragma unroll
                for (int m = 0; m < 4; ++m) {
                    GP_ST16(ob + (size_t)(128 * ai + 16 * m) * 1024, lo, pack8((acc[ai][0][m][0] + bv0) * sigm4(acc[ai][1][m][0] + bg0), (acc[ai][0][m][1] + bv1) * sigm4(acc[ai][1][m][1] + bg1))); GP_FENCE(); }
        } else {
            const int j = pn - 24, gi = j >> 2, c0 = 256 * (j & 3); bf16_t* ob = G + (size_t)gi * T_ROWS * 1024 + row0 * 1024 + c0; const float* bp = bgate + gi * 1024 + c0; const unsigned bo = (unsigned)(32 * wc + 8 * fq) * 4u;
            const f32x4 b00 = *(const f32x4*)((const char*)bp + bo), b01 = *(const f32x4*)((const char*)(bp + 4) + bo), b10 = *(const f32x4*)((const char*)(bp + 128) + bo), b11 = *(const f32x4*)((const char*)(bp + 132) + bo);
#pragma unroll
            for (int ai = 0; ai < 2; ++ai)
#pragma unroll
                for (int m = 0; m < 4; ++m) {
                    GP_ST16(ob + (size_t)(128 * ai + 16 * m) * 1024, lo, pack8(sigm4(acc[ai][0][m][0] + b00), sigm4(acc[ai][0][m][1] + b01)));
                    GP_ST16(ob + (size_t)(128 * ai + 16 * m) * 1024 + 128, lo, pack8(sigm4(acc[ai][1][m][0] + b10), sigm4(acc[ai][1][m][1] + b11))); GP_FENCE(); }
        }
    }
};

struct PhKV {
    static constexpr int NT = 16, KB = 1024, LDA = 1024; static constexpr bool GATHER = false;
    cptr MEMN, WT; bf16_t* KV; int Gd, c, nconv;
    __device__ __forceinline__ bool next(int i, Unit& u) const { int L = i * Gd + c; (void)nconv; if (L >= 64) return false; u.sub = L >> 5; u.pm = (L & 31) >> 3; u.pn = L & 7; u.aux = 0; return true; }
    __device__ __forceinline__ cptr a_base(const Unit& u) const { return MEMN + ((size_t)u.sub * 1024 + u.pm * 256) * 2048; }
    __device__ __forceinline__ cptr b_base(const Unit& u, int half) const { return WT + ((size_t)u.sub * 2048 + u.pn * 256 + 128 * half) * 2048; }
    __device__ __forceinline__ bool keep_acc(const Unit&) const { return false; }
    __device__ __forceinline__ void a_ready(const Unit&) const {}
    __device__ __forceinline__ void done(const Unit&) const {}
    __device__ __forceinline__ void epilogue(f32x4 (&acc)[2][2][4][2], const Unit& u, int wr, int wc, int fr, int fq) const {
        bf16_t* ob = KV + ((size_t)u.sub * 1024 + u.pm * 256 + 64 * wr) * 2048 + u.pn * 256; const unsigned lo = (unsigned)(fr * 2048 + 32 * wc + 8 * fq) * 2u;
#pragma unroll
        for (int ai = 0; ai < 2; ++ai)
#pragma unroll
            for (int m = 0; m < 4; ++m) {
#pragma unroll
                for (int bj = 0; bj < 2; ++bj) GP_ST16(ob + (size_t)(128 * ai + 16 * m) * 2048 + 128 * bj, lo, pack8(acc[ai][bj][m][0], acc[ai][bj][m][1]));
                GP_FENCE(); }
    }
};

__device__ __forceinline__ f32x4 ratio4(const f32x4 n, const f32x4 d) { f32x4 r;
#pragma unroll
    for (int j = 0; j < 4; ++j) r[j] = n[j] * __builtin_amdgcn_rcpf(fmaxf(d[j], 1e-30f));
    return r; }
struct PhOut3 {
    static constexpr int NT = 16, KB = 1024, LDA = 1024; static constexpr bool GATHER = false;
    cptr AC, WA; const float* bb; const bf16_t* G; bf16_t* MG; unsigned* pcnt; int Gd, c;
    __device__ __forceinline__ bool next(int i, Unit& u) const { const int Lt = (i / 3) * Gd + c; if (Lt >= 256) return false; tile_order(Lt, 64, 4, u.pm, u.pn); u.sub = i % 3; u.aux = 0; return true; }
    __device__ __forceinline__ cptr a_base(const Unit& u) const { return AC + (size_t)u.sub * (32 * MiB) + (size_t)u.pm * 256 * 2048; }
    __device__ __forceinline__ cptr b_base(const Unit& u, int half) const { return WA + (size_t)u.sub * (4 * MiB) + (size_t)(u.pn * 256 + 128 * half) * 2048; }
    __device__ __forceinline__ bool keep_acc(const Unit& u) const { return u.sub < 2; }
    __device__ __forceinline__ void a_ready(const Unit&) const {}
    __device__ __forceinline__ void done(const Unit& u) const { if (u.sub == 2) hook_publish(pcnt + 64 * u.pm); }
    __device__ __forceinline__ void epilogue(f32x4 (&acc)[2][2][4][2], const Unit& u, int wr, int wc, int fr, int fq) const {
        const size_t t0 = ((size_t)u.pm * 256 + 64 * wr) * 1024 + u.pn * 256; const size_t GS = (size_t)T_ROWS * 1024;
        const unsigned lo = (unsigned)(fr * 1024 + 32 * wc + 8 * fq) * 2u;
        if (u.sub < 2) {
            const bf16_t* gn = G + (u.sub == 0 ? 0 : GS) + t0; const bf16_t* gd = gn + GS; const unsigned bo = (unsigned)(32 * wc + 8 * fq) * 4u; const float* bp = bb + u.pn * 256; const float bsc = (u.sub == 1) ? 1.0f : 0.0f;
            f32x4 bv[2][2];
#pragma unroll
            for (int bj = 0; bj < 2; ++bj) { bv[bj][0] = *(const f32x4*)((const char*)(bp + 128 * bj) + bo) * bsc; bv[bj][1] = *(const f32x4*)((const char*)(bp + 128 * bj + 4) + bo) * bsc; }
#pragma unroll
            for (int ai = 0; ai < 2; ++ai) {
                u32x4 gnv[4][2], gdv[4][2];
#pragma unroll
                for (int m = 0; m < 4; ++m)
#pragma unroll
                    for (int bj = 0; bj < 2; ++bj) { const size_t o = (size_t)(128 * ai + 16 * m) * 1024 + 128 * bj; gnv[m][bj] = GP_LD16(gn + o, lo); gdv[m][bj] = GP_LD16(gd + o, lo); }
#pragma unroll
                for (int m = 0; m < 4; ++m)
#pragma unroll
                    for (int bj = 0; bj < 2; ++bj) { f32x4 n0, n1, d0, d1; unpack8(gnv[m][bj], n0, n1); unpack8(gdv[m][bj], d0, d1);
                        acc[ai][bj][m][0] = (acc[ai][bj][m][0] + bv[bj][0]) * ratio4(n0, d0); acc[ai][bj][m][1] = (acc[ai][bj][m][1] + bv[bj][1]) * ratio4(n1, d1); }
                GP_FENCE(); }
        } else {
            const bf16_t* g2 = G + 2 * GS + t0; bf16_t* ob = MG + t0;
#pragma unroll
            for (int ai = 0; ai < 2; ++ai) {
                u32x4 gv[4][2];
#pragma unroll
                for (int m = 0; m < 4; ++m)
#pragma unroll
                    for (int bj = 0; bj < 2; ++bj) gv[m][bj] = GP_LD16(g2 + (size_t)(128 * ai + 16 * m) * 1024 + 128 * bj, lo);
#pragma unroll
                for (int m = 0; m < 4; ++m)
#pragma unroll
                    for (int bj = 0; bj < 2; ++bj) { const size_t o = (size_t)(128 * ai + 16 * m) * 1024 + 128 * bj; f32x4 g0, g1; unpack8(gv[m][bj], g0, g1);
                        st16_buf(ob + o, lo, pack8(acc[ai][bj][m][0] * g0, acc[ai][bj][m][1] * g1)); }
                GP_FENCE(); }
        }
    }
};

struct PhWo {
    static constexpr int NT = 16, KB = 1024, LDA = 1024; static constexpr bool GATHER = false;
    cptr MG, WT; const float* xin_f; const bf16_t* xin_b; bf16_t* XBo; unsigned *pin, *pout, *tmo; int Gd, c;
    __device__ __forceinline__ bool next(int i, Unit& u) const { const int L = i * Gd + c; if (L >= 256) return false; tile_order(L, 64, 4, u.pm, u.pn); u.sub = 0; u.aux = 0; return true; }
    __device__ __forceinline__ cptr a_base(const Unit& u) const { return MG + (size_t)u.pm * 256 * 2048; }
    __device__ __forceinline__ cptr b_base(const Unit& u, int half) const { return WT + (size_t)(u.pn * 256 + 128 * half) * 2048; }
    __device__ __forceinline__ bool keep_acc(const Unit&) const { return false; }
    __device__ __forceinline__ void a_ready(const Unit& u) const { hook_wait(pin + 64 * u.pm, 32u, tmo); }
    __device__ __forceinline__ void done(const Unit& u) const { hook_publish(pout + 64 * u.pm); }
    __device__ __forceinline__ void epilogue(f32x4 (&acc)[2][2][4][2], const Unit& u, int wr, int wc, int fr, int fq) const {
        const size_t t0 = ((size_t)u.pm * 256 + 64 * wr) * 1024 + u.pn * 256; const unsigned lo2 = (unsigned)(fr * 1024 + 32 * wc + 8 * fq) * 2u, lo4 = lo2 * 2u;
        bf16_t* xb = XBo + t0;
        if (xin_f) {
            const float* xi = xin_f + t0;
#pragma unroll
            for (int ai = 0; ai < 2; ++ai)
#pragma unroll
                for (int mp = 0; mp < 2; ++mp) {
                    f32x4 xv[2][2][2];
#pragma unroll
                    for (int mm = 0; mm < 2; ++mm)
#pragma unroll
                        for (int bj = 0; bj < 2; ++bj) { const size_t o = (size_t)(128 * ai + 16 * (2 * mp + mm)) * 1024 + 128 * bj; xv[mm][bj][0] = *(const f32x4*)((const char*)(xi + o) + lo4); xv[mm][bj][1] = *(const f32x4*)((const char*)(xi + o + 4) + lo4); }
#pragma unroll
                    for (int mm = 0; mm < 2; ++mm)
#pragma unroll
                        for (int bj = 0; bj < 2; ++bj) { const int m = 2 * mp + mm; const size_t o = (size_t)(128 * ai + 16 * m) * 1024 + 128 * bj;
                            st16_buf(xb + o, lo2, pack8(xv[mm][bj][0] + acc[ai][bj][m][0], xv[mm][bj][1] + acc[ai][bj][m][1])); }
                    GP_FENCE(); }
        } else {
            const bf16_t* xi = xin_b + t0;
#pragma unroll
            for (int ai = 0; ai < 2; ++ai) {
                u32x4 xv[4][2];
#pragma unroll
                for (int m = 0; m < 4; ++m)
#pragma unroll
                    for (int bj = 0; bj < 2; ++bj) xv[m][bj] = GP_LD16(xi + (size_t)(128 * ai + 16 * m) * 1024 + 128 * bj, lo2);
#pragma unroll
                for (int m = 0; m < 4; ++m)
#pragma unroll
                    for (int bj = 0; bj < 2; ++bj) { f32x4 x0, x1; unpack8(xv[m][bj], x0, x1);
                        st16_buf(xb + (size_t)(128 * ai + 16 * m) * 1024 + 128 * bj, lo2, pack8(x0 + acc[ai][bj][m][0], x1 + acc[ai][bj][m][1])); }
                GP_FENCE(); }
        }
    }
};

struct MoeTab { const LAS int* tp; const LAS int* cn; };
__device__ __forceinline__ void moe_unit(const MoeTab& tb, int uidx, Unit& u) {
    const int tile = uidx >> 2; int e = 0;
    for (int k = 0; k < 32; ++k) if (__builtin_amdgcn_readfirstlane(tb.tp[k + 1]) <= tile) e = k + 1;
    const int tpe = __builtin_amdgcn_readfirstlane(tb.tp[e]);
    u.sub = e; u.pm = tile - tpe; u.pn = uidx & 3; u.aux = tpe;
}
constexpr unsigned MOE_SPIN_CAP = 1u << 20;
struct PhMoeGU {
    static constexpr int NT = 16, KB = 1024, LDA = 1024; static constexpr bool GATHER = true;
    cptr XB, WT; const int* list; const float* rsl; bf16_t* HID; unsigned* tcnt; MoeTab tb; int Gd, c;
    __device__ __forceinline__ bool next(int i, Unit& u) const { const int total = __builtin_amdgcn_readfirstlane(tb.tp[32]) * 4; const int L = i * Gd + c; if (L >= total) return false; moe_unit(tb, L, u); return true; }
    __device__ __forceinline__ cptr a_base(const Unit&) const { return XB; }
    __device__ __forceinline__ void a_offs(const Unit& u, int tid, unsigned (&off)[2][2]) const {
        const int n = __builtin_amdgcn_readfirstlane(tb.cn[u.sub]) - u.pm * 256; const int* lp = list + u.sub * 16384 + u.pm * 256;
#pragma unroll
        for (int i = 0; i < 2; ++i) { int R, C; stage_rc(tid * 16 + i * 8192, R, C);
#pragma unroll
            for (int h = 0; h < 2; ++h) { int idx = 128 * h + R; idx = idx < n ? idx : 0; const int tok = lp[idx]; off[h][i] = (unsigned)(tok * 1024 + C) * 2u; } }
    }
    __device__ __forceinline__ cptr b_base(const Unit& u, int half) const { return WT + ((size_t)u.sub * 1024 + (half ? 512 : 0) + 128 * u.pn) * 2048; }
    __device__ __forceinline__ bool keep_acc(const Unit&) const { return false; }
    __device__ __forceinline__ void a_ready(const Unit&) const {}
    __device__ __forceinline__ void done(const Unit& u) const {
        asm volatile("s_waitcnt vmcnt(0)" ::: "memory");
        if ((threadIdx.x & 63) == 0) __hip_atomic_fetch_add(tcnt + 64 * (u.aux + u.pm), 1u, __ATOMIC_RELAXED, __HIP_MEMORY_SCOPE_AGENT);
    }
    __device__ __forceinline__ void epilogue(f32x4 (&acc)[2][2][4][2], const Unit& u, int wr, int wc, int fr, int fq) const {
        const int n = __builtin_amdgcn_readfirstlane(tb.cn[u.sub]) - u.pm * 256; const float* rp = rsl + u.sub * 16384 + u.pm * 256;
        bf16_t* ob = HID + ((size_t)(u.aux + u.pm) * 256 + 64 * wr) * 512 + 128 * u.pn; const unsigned lo = (unsigned)(fr * 512 + 32 * wc + 8 * fq) * 2u;
        float rsv[2][4];
#pragma unroll
        for (int ai = 0; ai < 2; ++ai)
#pragma unroll
            for (int m = 0; m < 4; ++m) { int idx = 128 * ai + 64 * wr + 16 * m + fr; idx = idx < n ? idx : 0; rsv[ai][m] = rp[idx]; }
#pragma unroll
        for (int ai = 0; ai < 2; ++ai)
#pragma unroll
            for (int m = 0; m < 4; ++m) { const float s = rsv[ai][m];
                const f32x4 g0 = acc[ai][0][m][0] * s, g1 = acc[ai][0][m][1] * s;
                st16_buf(ob + (size_t)(128 * ai + 16 * m) * 512, lo, pack8(g0 * sigm4(g0) * (acc[ai][1][m][0] * s), g1 * sigm4(g1) * (acc[ai][1][m][1] * s))); GP_FENCE(); }
    }
};
struct PhMoeDn {
    static constexpr int NT = 8, KB = 512, LDA = 512; static constexpr bool GATHER = false;
    cptr HID, WT; bf16_t* Y; unsigned* tcnt; unsigned* tmo; MoeTab tb; int Gd, c;
    __device__ __forceinline__ bool next(int i, Unit& u) const {
        const int n = __builtin_amdgcn_readfirstlane(tb.tp[32]) * 4, H = n % Gd, nl = Gd - H, A = (H == 0) ? 0 : (n < 2 * nl ? n : 2 * nl);
        int na = 0; if (c >= H && H != 0) { const int li = c - H; na = (li < A ? 1 : 0) + (li + nl < A ? 1 : 0); }
        int uidx; if (i < na) uidx = (c - H) + i * nl; else { uidx = A + c + Gd * (i - na); if (uidx >= n) return false; }
        moe_unit(tb, uidx, u); return true;
    }
    __device__ __forceinline__ cptr a_base(const Unit& u) const { return HID + (size_t)(u.aux + u.pm) * 256 * 1024; }
    __device__ __forceinline__ cptr b_base(const Unit& u, int half) const { return WT + ((size_t)u.sub * 1024 + 256 * u.pn + 128 * half) * 1024; }
    __device__ __forceinline__ bool keep_acc(const Unit&) const { return false; }
    __device__ __forceinline__ void a_ready(const Unit& u) const {
        if (threadIdx.x < 64) {
            unsigned* p = tcnt + 64 * (u.aux + u.pm); unsigned spins = 0;
            while ((unsigned)__builtin_amdgcn_readfirstlane(__hip_atomic_load(p, __ATOMIC_RELAXED, __HIP_MEMORY_SCOPE_AGENT)) < 32u) {
                if ((++spins & 255u) == 0u && (__builtin_amdgcn_readfirstlane(__hip_atomic_load(tmo, __ATOMIC_RELAXED, __HIP_MEMORY_SCOPE_AGENT)) != 0u || spins > MOE_SPIN_CAP)) { if (threadIdx.x == 0) __hip_atomic_store(tmo, 1u, __ATOMIC_RELAXED, __HIP_MEMORY_SCOPE_AGENT); break; }
                __builtin_amdgcn_s_sleep(2); }
            __builtin_amdgcn_fence(__ATOMIC_ACQUIRE, "agent");
            asm volatile("s_waitcnt vmcnt(0)" ::: "memory");
        }
        asm volatile("" ::: "memory"); __builtin_amdgcn_s_barrier(); asm volatile("" ::: "memory");
    }
    __device__ __forceinline__ void done(const Unit&) const {}
    __device__ __forceinline__ void epilogue(f32x4 (&acc)[2][2][4][2], const Unit& u, int wr, int wc, int fr, int fq) const {
        bf16_t* ob = Y + ((size_t)(u.aux + u.pm) * 256 + 64 * wr) * 1024 + 256 * u.pn; const unsigned lo = (unsigned)(fr * 1024 + 32 * wc + 8 * fq) * 2u;
#pragma unroll
        for (int ai = 0; ai < 2; ++ai)
#pragma unroll
            for (int m = 0; m < 4; ++m) {
#pragma unroll
                for (int bj = 0; bj < 2; ++bj) GP_ST16(ob + (size_t)(128 * ai + 16 * m) * 1024 + 128 * bj, lo, pack8(acc[ai][bj][m][0], acc[ai][bj][m][1]));
                GP_FENCE(); }
    }
};
}
namespace tp {
using ge::f32x4; using ge::u32x4; using ge::bf16x8;
typedef float f32x2 __attribute__((ext_vector_type(2)));
typedef unsigned u32x2 __attribute__((ext_vector_type(2)));
typedef short s16x4 __attribute__((ext_vector_type(4)));
#define LDS_WAIT() asm volatile("s_waitcnt lgkmcnt(0)" ::: "memory")
__device__ __forceinline__ float wave_sum(float v) {
#pragma unroll
    for (int o = 1; o < 64; o <<= 1) v += __shfl_xor(v, o);
    return v;
}
template <int CTRL> __device__ __forceinline__ float dpp_f(float v) { return __int_as_float(__builtin_amdgcn_update_dpp(0, __float_as_int(v), CTRL, 0xF, 0xF, true)); }
__device__ __forceinline__ float row_sum16(float v) {
    v += dpp_f<0xB1>(v); v += dpp_f<0x4E>(v); v += dpp_f<0x141>(v); v += dpp_f<0x140>(v); return v; }
__device__ __forceinline__ float wave_total(float v) {
    v = row_sum16(v);
    return (__int_as_float(__builtin_amdgcn_readlane(__float_as_int(v), 0)) + __int_as_float(__builtin_amdgcn_readlane(__float_as_int(v), 16)))
         + (__int_as_float(__builtin_amdgcn_readlane(__float_as_int(v), 32)) + __int_as_float(__builtin_amdgcn_readlane(__float_as_int(v), 48))); }
__device__ __forceinline__ unsigned pk2(float lo, float hi) { return ge::cvt_pk_bf16(lo, hi); }
__device__ __forceinline__ float blo(unsigned w) { return __uint_as_float(w << 16); }
__device__ __forceinline__ float bhi(unsigned w) { return __uint_as_float(w & 0xffff0000u); }

typedef const GAS float* const __attribute__((address_space(4)))* KIn;
constexpr int IT_IN = 16 * 288, IT_SQ = 512, IT_KV = 1024, IT_GU = 32 * 512, IT_DN = 32 * 256, IT_LAYER = IT_IN + 4 * IT_SQ + IT_KV + IT_GU + IT_DN;
struct ItemDesc { const float* W; bf16_t* WT; const float* gk; int K, N, k0, n0; };
__device__ __forceinline__ ItemDesc p0_decode(KIn in, unsigned char* ws, int it) {
    ItemDesc d; const int l = it / IT_LAYER; int r = it % IT_LAYER; int item, ii, gi = -1; size_t so, wo; d.K = 1024; d.N = 1024;
    if (r < IT_IN) { ii = 4; so = (size_t)l * 1024 * 9216; d.N = 9216; wo = W_IN + (size_t)l * 18 * MiB; gi = 2; item = r; }
    else if ((r -= IT_IN) < 4 * IT_SQ) { const int q = r >> 9; item = r & 511; ii = q == 0 ? 7 : q == 1 ? 13 : q == 2 ? 16 : 17; so = (size_t)l * 1048576; wo = W_OA + (size_t)q * 4 * MiB + (size_t)l * 2 * MiB; }
    else if ((r -= 4 * IT_SQ) < IT_KV) { ii = 15; so = (size_t)l * 2097152; d.N = 2048; wo = W_KV + (size_t)l * 4 * MiB; item = r; }
    else if ((r -= IT_KV) < IT_GU) { const int e = r >> 9; ii = 23; so = ((size_t)l * 32 + e) * 1048576; wo = W_GU + ((size_t)l * 32 + e) * 2 * MiB; gi = 18; item = r & 511; }
    else { r -= IT_GU; const int e = r >> 8; ii = 24; so = ((size_t)l * 32 + e) * 524288; d.K = 512; wo = W_DN + ((size_t)l * 32 + e) * MiB; item = r & 255; }
    d.W = (const float*)in[ii] + so; d.WT = (bf16_t*)(ws + wo); d.gk = gi >= 0 ? (const float*)in[gi] + l * 1024 : nullptr;
    const int nblk = d.N / 32; d.k0 = 64 * (item / nblk); d.n0 = 32 * (item % nblk); return d;
}
struct ItemRt { const float* src; bf16_t* dst; const float* gk; unsigned N4, K2; bool hg; };
__device__ __forceinline__ ItemRt p0_rt(const ItemDesc& d) { ItemRt r; r.src = d.W + (size_t)d.k0 * d.N + d.n0; r.dst = d.WT + (size_t)d.n0 * d.K + d.k0; r.hg = d.gk != nullptr; r.gk = r.hg ? d.gk + d.k0 : d.W; r.N4 = (unsigned)d.N * 4u; r.K2 = (unsigned)d.K * 2u; return r; }
__device__ __forceinline__ void p0_load(const ItemRt& r, int lane, f32x4 (&tv)[8], f32x4 (&g)[2]) {
    const unsigned lo = (unsigned)(lane >> 3) * 8u * r.N4 + (unsigned)(lane & 7) * 16u;
#pragma unroll
    for (int i = 0; i < 8; ++i) tv[i] = __builtin_nontemporal_load((const f32x4*)((const char*)r.src + (size_t)i * r.N4 + lo));
    g[0] = *(const f32x4*)((const char*)r.gk + (unsigned)(lane >> 3) * 32u); g[1] = *(const f32x4*)((const char*)r.gk + 16 + (unsigned)(lane >> 3) * 32u);
}
__device__ __forceinline__ void p0_store(const ItemRt& r, int lane, f32x4 (&tv)[8], const f32x4 (&g)[2]) {
    if (r.hg) { tv[0] *= g[0].x; tv[1] *= g[0].y; tv[2] *= g[0].z; tv[3] *= g[0].w; tv[4] *= g[1].x; tv[5] *= g[1].y; tv[6] *= g[1].z; tv[7] *= g[1].w; }
    const unsigned so = (unsigned)(lane & 7) * 4u * r.K2 + (unsigned)(lane >> 3) * 16u;
#pragma unroll
    for (int j = 0; j < 4; ++j) { u32x4 o; o.x = pk2(tv[0][j], tv[1][j]); o.y = pk2(tv[2][j], tv[3][j]); o.z = pk2(tv[4][j], tv[5][j]); o.w = pk2(tv[6][j], tv[7][j]);
        __builtin_nontemporal_store(o, (u32x4*)((char*)r.dst + (size_t)j * r.K2 + so)); }
}
constexpr int IT_EARLY = IT_IN + 2 * IT_KV, IT_LATE = 2 * IT_LAYER - IT_EARLY;
__device__ __forceinline__ int p0_early_item(int e) { return e < IT_IN ? e : (e < IT_IN + IT_KV ? e + 4 * IT_SQ : IT_LAYER + IT_IN + 4 * IT_SQ + (e - IT_IN - IT_KV)); }
__device__ __forceinline__ int p0_late_item(int j) {
    if (j < 4 * IT_SQ) return IT_IN + j;
    j -= 4 * IT_SQ; if (j < IT_GU + IT_DN) return IT_IN + 4 * IT_SQ + IT_KV + j;
    j -= IT_GU + IT_DN; if (j < IT_IN + 4 * IT_SQ) return IT_LAYER + j;
    j -= IT_IN + 4 * IT_SQ; return IT_LAYER + IT_IN + 4 * IT_SQ + IT_KV + j;
}
template <int WHICH  >
__device__ __forceinline__ void p0_items(KIn in, unsigned char* ws, int first, int stride, int lane) {
    constexpr int COUNT = WHICH == 0 ? 2 * IT_LAYER : WHICH == 1 ? IT_EARLY : IT_LATE;
#define P0_MAP(i) (WHICH == 0 ? (i) : WHICH == 1 ? p0_early_item(i) : p0_late_item(i))
    f32x4 t0[8], t1[8], t2[8], t3[8], g0[2], g1[2], g2[2], g3[2]; ItemRt r0, r1, r2, r3; int it = first;
#define P0_ISSUE(s, idx) { const int ii_ = (idx) < COUNT ? (idx) : COUNT - 1; r##s = p0_rt(p0_decode(in, ws, P0_MAP(ii_))); p0_load(r##s, lane, t##s, g##s); }
#define P0_STEP(s) { if (it < COUNT) p0_store(r##s, lane, t##s, g##s); P0_ISSUE(s, it + 4 * stride) it += stride; }
    P0_ISSUE(0, it) P0_ISSUE(1, it + stride) P0_ISSUE(2, it + 2 * stride) P0_ISSUE(3, it + 3 * stride)
    while (it < COUNT) { P0_STEP(0) P0_STEP(1) P0_STEP(2) P0_STEP(3) }
#undef P0_STEP
#undef P0_ISSUE
#undef P0_MAP
}
__device__ __forceinline__ void p0_prologue(KIn in, unsigned char* ws, int gw, int NGW, int lane, bool background) {
    if (background) p0_items<1>(in, ws, gw, NGW, lane); else p0_items<0>(in, ws, gw, NGW, lane);
    asm volatile("" : "+s"(in), "+s"(ws));
    { const float *w_group = (const float*)in[19], *w_router = (const float*)in[21], *ffn_g = (const float*)in[18]; bf16_t* WRT = (bf16_t*)(ws + W_RT);
      for (int i = gw * 64 + lane; i < 2 * 48 * 1024; i += NGW * 64) { const int l = i / 49152, r = i % 49152, j = r >> 10, k = r & 1023;
        float w = 0.f; if (j < 4) w = w_group[((size_t)l * 1024 + k) * 4 + j]; else if (j < 36) w = w_router[((size_t)l * 1024 + k) * 32 + (j - 4)];
        w *= ffn_g[l * 1024 + k]; const unsigned hb = pk2(w, 0.f) & 0xffffu; const float hf = __uint_as_float(hb << 16);
        WRT[(size_t)l * 98304 + r] = (bf16_t)hb; WRT[(size_t)l * 98304 + 49152 + r] = (bf16_t)(pk2(w - hf, 0.f) & 0xffffu); } }
    asm volatile("" : "+s"(in), "+s"(ws));
    { const float* x = (const float*)in[0]; float* RS = (float*)(ws + WS_RT + RT_RS); bf16_t* XB = (bf16_t*)(ws + WS_XB);
      for (int row = gw; row < T_ROWS; row += 2 * NGW) { const int row2 = row + NGW;
        const f32x4* xr = (const f32x4*)(x + (size_t)row * 1024) + lane; const f32x4* xr2 = (const f32x4*)(x + (size_t)(row2 < T_ROWS ? row2 : row) * 1024) + lane; f32x4 v[4], v2[4]; float s = 0.f, s2 = 0.f;
#pragma unroll
        for (int j = 0; j < 4; ++j) v[j] = xr[64 * j];
#pragma unroll
        for (int j = 0; j < 4; ++j) v2[j] = xr2[64 * j];
#pragma unroll
        for (int j = 0; j < 4; ++j) { s += (v[j].x * v[j].x + v[j].y * v[j].y) + (v[j].z * v[j].z + v[j].w * v[j].w); s2 += (v2[j].x * v2[j].x + v2[j].y * v2[j].y) + (v2[j].z * v2[j].z + v2[j].w * v2[j].w); }
        s = wave_sum(s); s2 = wave_sum(s2); const float rstd = rsqrtf(s * (1.0f / 1024.0f) + 1e-6f), rstd2 = rsqrtf(s2 * (1.0f / 1024.0f) + 1e-6f);
        if (lane == 0) RS[row] = rstd;
        u32x2* o = (u32x2*)(XB + (size_t)row * 1024) + lane;
#pragma unroll
        for (int j = 0; j < 4; ++j) { u32x2 w; w.x = pk2(v[j].x * rstd, v[j].y * rstd); w.y = pk2(v[j].z * rstd, v[j].w * rstd); o[64 * j] = w; }
        if (row2 < T_ROWS) { if (lane == 0) RS[row2] = rstd2; u32x2* o2 = (u32x2*)(XB + (size_t)row2 * 1024) + lane;
#pragma unroll
            for (int j = 0; j < 4; ++j) { u32x2 w; w.x = pk2(v2[j].x * rstd2, v2[j].y * rstd2); w.y = pk2(v2[j].z * rstd2, v2[j].w * rstd2); o2[64 * j] = w; } } } }
    asm volatile("" : "+s"(in), "+s"(ws));
    { const float *mem = (const float*)in[1], *mem_g = (const float*)in[3]; bf16_t* MEMN = (bf16_t*)(ws + WS_MEMN);
      for (int rr = gw; rr < 2048; rr += NGW) { const int l = rr >> 10, row = rr & 1023; const f32x4* xr = (const f32x4*)(mem + (size_t)row * 1024) + lane; const f32x4* gr = (const f32x4*)(mem_g + l * 1024) + lane; f32x4 v[4]; float s = 0.f;
#pragma unroll
        for (int j = 0; j < 4; ++j) { v[j] = xr[64 * j]; s += (v[j].x * v[j].x + v[j].y * v[j].y) + (v[j].z * v[j].z + v[j].w * v[j].w); }
        s = wave_sum(s); const float rstd = rsqrtf(s * (1.0f / 1024.0f) + 1e-6f);
        u32x2* o = (u32x2*)(MEMN + ((size_t)l * 1024 + row) * 1024) + lane;
#pragma unroll
        for (int j = 0; j < 4; ++j) { const f32x4 g = gr[64 * j]; u32x2 w; w.x = pk2(v[j].x * rstd * g.x, v[j].y * rstd * g.y); w.y = pk2(v[j].z * rstd * g.z, v[j].w * rstd * g.w); o[64 * j] = w; } } }
}

__device__ __forceinline__ void aconv_phase(const bf16_t* CV, const bf16_t* GB, const float* w, bf16_t* AC, int vcu, int G, int tid) {
    int c = 8 * (tid & 127); asm volatile("" : "+v"(c));
    const unsigned co2 = (unsigned)c * 2u, co4 = (unsigned)c * 4u; const int sub = __builtin_amdgcn_readfirstlane(tid >> 7);
    const f32x4 w0a = *(const f32x4*)((const char*)w + co4), w0b = *(const f32x4*)((const char*)(w + 4) + co4), w1a = *(const f32x4*)((const char*)(w + 1024) + co4), w1b = *(const f32x4*)((const char*)(w + 1028) + co4),
                w2a = *(const f32x4*)((const char*)(w + 2048) + co4), w2b = *(const f32x4*)((const char*)(w + 2052) + co4);
    for (int blk = vcu * 4 + sub; blk < 2048; blk += G * 4) {
        const size_t row0 = (size_t)blk * 8; const bool first = ((row0 & 4095) == 0);
        const bf16_t* cvu = CV + row0 * 1024; const bf16_t* gbu = GB + row0 * 1024; bf16_t* acu = AC + row0 * 1024;
        f32x4 p2a = {0.f, 0.f, 0.f, 0.f}, p2b = p2a, p1a = p2a, p1b = p2a;
        if (!first) { ge::unpack8(*(const u32x4*)((const char*)(cvu - 2048) + co2), p2a, p2b); ge::unpack8(*(const u32x4*)((const char*)(cvu - 1024) + co2), p1a, p1b); }
#pragma unroll
        for (int j = 0; j < 8; ++j) { f32x4 ca, cb, ga, gb; ge::unpack8(*(const u32x4*)((const char*)(cvu + j * 1024) + co2), ca, cb); ge::unpack8(*(const u32x4*)((const char*)(gbu + j * 1024) + co2), ga, gb);
            const f32x4 sa = w0a * p2a + w1a * p1a + w2a * ca, sb = w0b * p2b + w1b * p1b + w2b * cb;
            *(u32x4*)((char*)(acu + j * 1024) + co2) = ge::pack8(ga * sa, gb * sb);
            p2a = p1a; p2b = p1b; p1a = ca; p1b = cb; }
    }
}

__device__ __forceinline__ void bconv_phase(const bf16_t* U, const float* w, const float* cb, const float* lg, const float* lb, bf16_t* UB, LAS unsigned char* lds, int vcu, int G, int tid) {
    LAS float* red = (LAS float*)lds;
    int par = 0;
    int c0 = 2 * tid; asm volatile("" : "+v"(c0));
    const unsigned co2 = (unsigned)c0 * 2u, co4 = (unsigned)c0 * 4u;
    const int wave = __builtin_amdgcn_readfirstlane(tid >> 6);
    f32x2 wk[31];
#pragma unroll
    for (int k = 0; k < 31; ++k) wk[k] = *(const f32x2*)((const char*)(w + k * 1024) + co4);
    const f32x2 cbv = *(const f32x2*)((const char*)cb + co4), lgv = *(const f32x2*)((const char*)lg + co4), lbv = *(const f32x2*)((const char*)lb + co4);
    for (int grp = vcu; grp < T_ROWS / 64; grp += G) {
        const size_t row0 = (size_t)grp * 64; const bool first = ((row0 & 4095) == 0);
        int lane = tid & 63; asm volatile("" : "+v"(lane));
        unsigned uu[46], nx[16];
#pragma unroll
        for (int i = 0; i < 30; ++i) { uu[i] = 0u; if (!first) uu[i] = *(const unsigned*)((const char*)(U + (row0 + i - 30) * 1024) + co2); }
#pragma unroll
        for (int i = 30; i < 46; ++i) uu[i] = *(const unsigned*)((const char*)(U + (row0 + i - 30) * 1024) + co2);
#pragma unroll
        for (int sub = 0; sub < 4; ++sub) {
            const size_t r0 = row0 + 16 * sub;
            if (sub < 3) {
#pragma unroll
                for (int i = 0; i < 16; ++i) nx[i] = *(const unsigned*)((const char*)(U + (r0 + 16 + i) * 1024) + co2); }
            f32x2 acc[16];
#pragma unroll
            for (int j = 0; j < 16; ++j) acc[j] = cbv;
#pragma unroll
            for (int i = 0; i < 46; ++i) { const float lo = blo(uu[i]), hi = bhi(uu[i]);
#pragma unroll
                for (int j = 0; j < 16; ++j) { const int k = i - j; if (k >= 0 && k < 31) { acc[j].x += wk[k].x * lo; acc[j].y += wk[k].y * hi; } } }
            { float s1[16], s2[8];
#pragma unroll
              for (int i = 0; i < 16; ++i) { const float a0 = acc[i].x + acc[i].y, a1 = acc[i].x * acc[i].x + acc[i].y * acc[i].y;
                  auto rr = __builtin_amdgcn_permlane32_swap(__float_as_uint(a0), __float_as_uint(a1), false, false); s1[i] = __uint_as_float(rr[0]) + __uint_as_float(rr[1]); }
#pragma unroll
              for (int i = 0; i < 8; ++i) { auto rr = __builtin_amdgcn_permlane16_swap(__float_as_uint(s1[i]), __float_as_uint(s1[i + 8]), false, false); s2[i] = row_sum16(__uint_as_float(rr[0]) + __uint_as_float(rr[1])); }
              if ((lane & 15) == 0) { LAS f32x4* rw = (LAS f32x4*)(red + par * 256 + wave * 32 + 8 * (lane >> 4)); rw[0] = f32x4{s2[0], s2[1], s2[2], s2[3]}; rw[1] = f32x4{s2[4], s2[5], s2[6], s2[7]}; } }
            __syncthreads();
            float fsum = 0.f;
#pragma unroll
            for (int wv = 0; wv < 8; ++wv) fsum += red[par * 256 + wv * 32 + (lane & 31)];
            par ^= 1;
            float mu_l, rstd_l;
            { auto rr = __builtin_amdgcn_permlane16_swap(__float_as_uint(fsum), __float_as_uint(fsum), false, false);
              mu_l = __uint_as_float(rr[0]) * (1.0f / 1024.0f); const float var = __uint_as_float(rr[1]) * (1.0f / 1024.0f) - mu_l * mu_l; rstd_l = rsqrtf(fmaxf(var, 0.f) + 1e-6f); }
#pragma unroll
            for (int j = 0; j < 16; ++j) { const float mu = __int_as_float(__builtin_amdgcn_readlane(__float_as_int(mu_l), j)), rstd = __int_as_float(__builtin_amdgcn_readlane(__float_as_int(rstd_l), j));
                const float y0 = (acc[j].x - mu) * (rstd * lgv.x) + lbv.x, y1 = (acc[j].y - mu) * (rstd * lgv.y) + lbv.y;
                *(unsigned*)((char*)(UB + (r0 + j) * 1024) + co2) = pk2(y0 * ge::fsigm(y0), y1 * ge::fsigm(y1)); }
            if (sub < 3) {
#pragma unroll
                for (int i = 0; i < 30; ++i) uu[i] = uu[i + 16];
#pragma unroll
                for (int i = 0; i < 16; ++i) uu[30 + i] = nx[i]; }
        }
    }
    __syncthreads();
}

constexpr int ATT_PITCH = 544;
constexpr int ATT_LDS = 256 * ATT_PITCH;
__device__ __forceinline__ void att_load(const bf16_t* src  , int half, int tid, u32x4 (&v)[8]) {
    const unsigned go = (unsigned)((tid >> 5) * 2048 + (tid & 31) * 8) * 2u;
#pragma unroll
    for (int it = 0; it < 8; ++it) v[it] = *(const u32x4*)((const char*)(src + (size_t)(it + 8 * half) * 16 * 2048) + go);
}
__device__ __forceinline__ void att_store(LAS unsigned char* lds, int half, int tid, const u32x4 (&v)[8]) {
    const unsigned lo = (unsigned)((tid >> 5) * ATT_PITCH + (tid & 31) * 16);
#pragma unroll
    for (int it = 0; it < 8; ++it) *(LAS u32x4*)(lds + lo + (it + 8 * half) * 16 * ATT_PITCH) = v[it];
}
__device__ __forceinline__ void attn_phase(const bf16_t* Q, const bf16_t* KV, bf16_t* O, LAS unsigned char* lds, int vcu, int G, int tid) {
    int lane = tid & 63; asm volatile("" : "+v"(lane));
    const int wave = __builtin_amdgcn_readfirstlane(tid >> 6), l15 = lane & 15, kg = lane >> 4;
    const unsigned qlo = (unsigned)(l15 * 1024 + 8 * kg) * 2u, olo = (unsigned)(l15 * 1024 + 4 * kg) * 2u;
    const int klo = l15 * ATT_PITCH + 16 * kg;
    const int trb = (4 * kg + (l15 >> 2)) * ATT_PITCH + (4 * (l15 & 3)) * 2;
    for (int unit = vcu; unit < 256; unit += G) {
        const int b = unit >> 6, h = (unit >> 4) & 3, qb = unit & 15;
        const size_t row0 = (size_t)b * 4096 + qb * 256 + 32 * wave;
        const bf16_t* kvb = KV + (size_t)(b * 256) * 2048 + h * 256;
        bf16x8 qf[2][8];
        { u32x4 ka[8], kb2[8]; att_load(kvb, 0, tid, ka); att_load(kvb, 1, tid, kb2);
#pragma unroll
          for (int g = 0; g < 2; ++g) { const bf16_t* qu = Q + (row0 + 16 * g) * 1024 + h * 256;
#pragma unroll
              for (int ks = 0; ks < 8; ++ks) qf[g][ks] = *(const bf16x8*)((const char*)(qu + 32 * ks) + qlo); }
          att_store(lds, 0, tid, ka); att_store(lds, 1, tid, kb2); }
        __syncthreads();
        bf16x8 pf[2][8]; float linv[2];
        f32x4 S[2][16];
#pragma unroll
        for (int kb = 0; kb < 16; ++kb) { f32x4 s0 = {0.f, 0.f, 0.f, 0.f}, s1 = s0;
#pragma unroll
            for (int ks = 0; ks < 8; ++ks) { const bf16x8 kf = *(const LAS bf16x8*)(lds + klo + kb * 16 * ATT_PITCH + ks * 64);
                s0 = __builtin_amdgcn_mfma_f32_16x16x32_bf16(kf, qf[0][ks], s0, 0, 0, 0); s1 = __builtin_amdgcn_mfma_f32_16x16x32_bf16(kf, qf[1][ks], s1, 0, 0, 0); }
            S[0][kb] = s0; S[1][kb] = s1; if (kb & 1) __builtin_amdgcn_sched_barrier(0); }
        u32x4 va[8], vb[8]; att_load(kvb + 1024, 0, tid, va);
#pragma unroll
        for (int g = 0; g < 2; ++g) {
            if (g == 1) att_load(kvb + 1024, 1, tid, vb);
            float m = S[g][0][0];
#pragma unroll
            for (int kb = 0; kb < 16; ++kb)
#pragma unroll
                for (int r = 0; r < 4; ++r) m = fmaxf(m, S[g][kb][r]);
            m = fmaxf(m, __shfl_xor(m, 16)); m = fmaxf(m, __shfl_xor(m, 32));
            float l = 0.f;
#pragma unroll
            for (int kb = 0; kb < 16; ++kb)
#pragma unroll
                for (int r = 0; r < 4; ++r) { const float p = __builtin_amdgcn_exp2f((S[g][kb][r] - m) * 0.09016844005556021f); S[g][kb][r] = p; l += p; }
            l += __shfl_xor(l, 16); l += __shfl_xor(l, 32);
            linv[g] = 1.0f / l;
#pragma unroll
            for (int kk = 0; kk < 8; ++kk) { const u32x4 w = ge::pack8(S[g][2 * kk], S[g][2 * kk + 1]); pf[g][kk] = __builtin_bit_cast(bf16x8, w); }
            __builtin_amdgcn_sched_barrier(0);
        }
        __syncthreads();
        att_store(lds, 0, tid, va); att_store(lds, 1, tid, vb);
        __syncthreads();
        bf16_t* ou = O + row0 * 1024 + h * 256;
#pragma unroll 1
        for (int db = 0; db < 16; ++db) { f32x4 o0 = {0.f, 0.f, 0.f, 0.f}, o1 = o0;
#pragma unroll
            for (int kk = 0; kk < 8; ++kk) { const LAS unsigned char* p = lds + trb + (32 * kk) * ATT_PITCH + db * 32;
                const s16x4 lo = __builtin_bit_cast(s16x4, __builtin_amdgcn_ds_read_tr16_b64_v4i16((LAS s16x4*)p));
                const s16x4 hi = __builtin_bit_cast(s16x4, __builtin_amdgcn_ds_read_tr16_b64_v4i16((LAS s16x4*)(p + 16 * ATT_PITCH)));
                const bf16x8 vf = __builtin_shufflevector(lo, hi, 0, 1, 2, 3, 4, 5, 6, 7);
                o0 = __builtin_amdgcn_mfma_f32_16x16x32_bf16(vf, pf[0][kk], o0, 0, 0, 0); o1 = __builtin_amdgcn_mfma_f32_16x16x32_bf16(vf, pf[1][kk], o1, 0, 0, 0); }
            u32x2 w0, w1; w0.x = pk2(o0[0] * linv[0], o0[1] * linv[0]); w0.y = pk2(o0[2] * linv[0], o0[3] * linv[0]); w1.x = pk2(o1[0] * linv[1], o1[1] * linv[1]); w1.y = pk2(o1[2] * linv[1], o1[3] * linv[1]);
            *(u32x2*)((char*)(ou + 16 * db) + olo) = w0; *(u32x2*)((char*)(ou + 16 * 1024 + 16 * db) + olo) = w1; }
        __syncthreads();
    }
}

struct RouteArgs { unsigned* pcnt; unsigned* tmo; const bf16_t* X; const bf16_t* WR; const float* bg; const float* br; float* RS; int* tok_e; int* tok_pos; float* tok_w; int* cnt; int* list; float* rsl; };
constexpr int RT_PITCH = 1040;
__device__ __forceinline__ void route_phase(const RouteArgs& a, LAS unsigned char* lds, int vcu, int G, int tid) {
    const int wave = __builtin_amdgcn_readfirstlane(tid >> 6), blk = wave >> 1, kh = wave & 1;
    int lane = tid & 63; asm volatile("" : "+v"(lane));
    const int l15 = lane & 15, kg = lane >> 4;
    LAS unsigned char* WH = lds; LAS unsigned char* WL = lds + 36 * RT_PITCH;
    LAS float* ex = (LAS float*)(lds + 2 * 36 * RT_PITCH);
    LAS float* T = ex + 4 * 13 * 64;
    LAS float* SS = T + 64 * 49;
    const unsigned xo = (unsigned)(l15 * 1024 + 8 * kg) * 2u;
    int brow[3];
#pragma unroll
    for (int nb = 0; nb < 3; ++nb) { const int r = 16 * nb + l15; brow[nb] = (r < 36 ? r : 35) * RT_PITCH + 16 * kg; }
    for (int grp = vcu; grp < T_ROWS / 64; grp += G) {
        u32x4 wst[9];
#define RT_WLOAD(st) do { _Pragma("unroll") for (int it = 0; it < 9; ++it) { const int c = tid + 512 * it, part = c / 2304, rr = (c % 2304) >> 6, cc = c & 63; \
            wst[it] = *(const u32x4*)(a.WR + (size_t)part * 49152 + rr * 1024 + 512 * (st) + cc * 8); } } while (0)
#define RT_WSTORE() do { _Pragma("unroll") for (int it = 0; it < 9; ++it) { const int c = tid + 512 * it, part = c / 2304, rr = (c % 2304) >> 6, cc = c & 63; \
            *(LAS u32x4*)(lds + part * 36 * RT_PITCH + rr * RT_PITCH + cc * 16) = wst[it]; } } while (0)
        RT_WLOAD(0);
        if (a.pcnt) {
            if (tid < 64) { unsigned* p = a.pcnt + 64 * (grp >> 2); unsigned spins = 0;
                while ((unsigned)__builtin_amdgcn_readfirstlane(__hip_atomic_load(p, __ATOMIC_RELAXED, __HIP_MEMORY_SCOPE_AGENT)) < 32u) {
                    if ((++spins & 255u) == 0u && (__builtin_amdgcn_readfirstlane(__hip_atomic_load(a.tmo, __ATOMIC_RELAXED, __HIP_MEMORY_SCOPE_AGENT)) != 0u || spins > (1u << 20))) { if (tid == 0) __hip_atomic_store(a.tmo, 1u, __ATOMIC_RELAXED, __HIP_MEMORY_SCOPE_AGENT); break; }
                    __builtin_amdgcn_s_sleep(2); }
                __builtin_amdgcn_fence(__ATOMIC_ACQUIRE, "agent"); asm volatile("s_waitcnt vmcnt(0)" ::: "memory"); }
            __syncthreads(); }
        f32x4 acc[3]; float ss = 0.f;
#pragma unroll
        for (int nb = 0; nb < 3; ++nb) acc[nb] = (f32x4){0.f, 0.f, 0.f, 0.f};
        u32x4 xa[2][8];
#pragma unroll
        for (int st = 0; st < 2; ++st) { const bf16_t* xu = a.X + ((size_t)grp * 64 + 16 * blk) * 1024 + 512 * st + 256 * kh;
#pragma unroll
            for (int i = 0; i < 8; ++i) xa[st][i] = *(const u32x4*)((const char*)(xu + 32 * i) + xo); }
#pragma unroll
        for (int st = 0; st < 2; ++st) {
            RT_WSTORE();
            if (st == 0) RT_WLOAD(1);
            __syncthreads();
#pragma unroll
            for (int i = 0; i < 8; ++i) {
                f32x4 x0, x1; ge::unpack8(xa[st][i], x0, x1);
                ss += (x0.x * x0.x + x0.y * x0.y) + (x0.z * x0.z + x0.w * x0.w) + (x1.x * x1.x + x1.y * x1.y) + (x1.z * x1.z + x1.w * x1.w);
                const bf16x8 ah = __builtin_bit_cast(bf16x8, xa[st][i]);
#pragma unroll
                for (int nb = 0; nb < 3; ++nb) { const int off = brow[nb] + (8 * kh + i) * 64;
                    const bf16x8 bh = *(const LAS bf16x8*)(WH + off), bl = *(const LAS bf16x8*)(WL + off);
                    acc[nb] = __builtin_amdgcn_mfma_f32_16x16x32_bf16(ah, bh, acc[nb], 0, 0, 0); acc[nb] = __builtin_amdgcn_mfma_f32_16x16x32_bf16(ah, bl, acc[nb], 0, 0, 0); }
            }
            __syncthreads();
        }
#undef RT_WLOAD
#undef RT_WSTORE
        ss += __shfl_xor(ss, 16); ss += __shfl_xor(ss, 32);
        if (kh == 1) {
#pragma unroll
            for (int nb = 0; nb < 3; ++nb)
#pragma unroll
                for (int r = 0; r < 4; ++r) ex[(blk * 13 + nb * 4 + r) * 64 + lane] = acc[nb][r];
            ex[(blk * 13 + 12) * 64 + lane] = ss; }
        __syncthreads();
        LAS int* lc = (LAS int*)(SS + 64);
        if (tid < 32) lc[tid] = 0;
        int ea = 0, eb = 0, pa = 0, pb = 0; float myr = 0.f, cw0 = 0.f, cw1 = 0.f; const bool sel = (kh == 0) && (lane < 16);
        if (kh == 0) {
#pragma unroll
            for (int nb = 0; nb < 3; ++nb)
#pragma unroll
                for (int r = 0; r < 4; ++r) T[(16 * blk + 4 * kg + r) * 49 + 16 * nb + l15] = acc[nb][r] + ex[(blk * 13 + nb * 4 + r) * 64 + lane];
            if (kg == 0) SS[16 * blk + l15] = ss + ex[(blk * 13 + 12) * 64 + lane];
        }
        __syncthreads();
        if (sel) {
            const int lr = 16 * blk + lane; const LAS float* lp = T + lr * 49; myr = rsqrtf(SS[lr] * (1.0f / 1024.0f) + 1e-6f);
            float gm = lp[0] * myr + a.bg[0]; int gs = 0; float lgv[4]; lgv[0] = gm;
#pragma unroll
            for (int j = 1; j < 4; ++j) { lgv[j] = lp[j] * myr + a.bg[j]; if (lgv[j] > gm) { gm = lgv[j]; gs = j; } }
            float gsum = 0.f;
#pragma unroll
            for (int j = 0; j < 4; ++j) gsum += __expf(lgv[j] - gm);
            const float gpr = 1.0f / gsum;
            float e8[8];
#pragma unroll
            for (int j = 0; j < 8; ++j) e8[j] = lp[4 + gs * 8 + j] * myr + a.br[gs * 8 + j];
            int i0 = 0; float m0 = e8[0];
#pragma unroll
            for (int j = 1; j < 8; ++j) if (e8[j] > m0) { m0 = e8[j]; i0 = j; }
            int i1 = -1; float m1 = -3.0e38f;
#pragma unroll
            for (int j = 0; j < 8; ++j) if (j != i0 && e8[j] > m1) { m1 = e8[j]; i1 = j; }
            const float d = __expf(m1 - m0); cw0 = gpr / (1.0f + d); cw1 = gpr * d / (1.0f + d);
            ea = gs * 8 + i0; eb = gs * 8 + i1;
            pa = __hip_atomic_fetch_add(&lc[ea], 1, __ATOMIC_RELAXED, __HIP_MEMORY_SCOPE_WORKGROUP); pb = __hip_atomic_fetch_add(&lc[eb], 1, __ATOMIC_RELAXED, __HIP_MEMORY_SCOPE_WORKGROUP);
        }
        __syncthreads();
        if (tid < 32) { const int n = lc[tid]; lc[32 + tid] = n > 0 ? atomicAdd(&a.cnt[tid * CNT_STRIDE], n) : 0; }
        __syncthreads();
        if (sel) {
            const int row = grp * 64 + 16 * blk + lane; pa += lc[32 + ea]; pb += lc[32 + eb];
            a.list[ea * 16384 + pa] = row; a.list[eb * 16384 + pb] = row; a.rsl[ea * 16384 + pa] = myr; a.rsl[eb * 16384 + pb] = myr;
            a.RS[row] = myr; a.tok_e[row * 2] = ea; a.tok_e[row * 2 + 1] = eb; a.tok_pos[row * 2] = pa; a.tok_pos[row * 2 + 1] = pb;
            a.tok_w[row * 2] = cw0; a.tok_w[row * 2 + 1] = cw1;
        }
        __syncthreads();
    }
}

__device__ __forceinline__ void combine_phase(bf16_t* XB, bf16_t* XR, float* OUT, const bf16_t* Y, const int* tok_e, const int* tok_pos, const float* tok_w, const LAS int* tpre, const float* gf, bool final_layer, int gw, int NGW, int lane) {
    for (int r8 = gw; r8 < T_ROWS / 8; r8 += NGW) {
        const int row0 = r8 * 8;
        int sl = 0; float wv = 0.f;
        if (lane < 16) { const int e = tok_e[row0 * 2 + lane]; sl = tpre[e] * 256 + tok_pos[row0 * 2 + lane]; wv = tok_w[row0 * 2 + lane]; }
#pragma unroll
        for (int pr = 0; pr < 4; ++pr) {
            u32x2 xv[2][4], ya[2][4], yb[2][4]; float w0[2], w1[2];
#pragma unroll
            for (int q = 0; q < 2; ++q) { const int k = 2 * pr + q;
                const size_t s0 = (size_t)__builtin_amdgcn_readlane(sl, 2 * k), s1 = (size_t)__builtin_amdgcn_readlane(sl, 2 * k + 1);
                w0[q] = __int_as_float(__builtin_amdgcn_readlane(__float_as_int(wv), 2 * k)); w1[q] = __int_as_float(__builtin_amdgcn_readlane(__float_as_int(wv), 2 * k + 1));
                const u32x2* xr = (const u32x2*)(XB + (size_t)(row0 + k) * 1024) + lane; const u32x2* y0 = (const u32x2*)(Y + s0 * 1024) + lane; const u32x2* y1 = (const u32x2*)(Y + s1 * 1024) + lane;
#pragma unroll
                for (int j = 0; j < 4; ++j) { xv[q][j] = xr[64 * j]; ya[q][j] = y0[64 * j]; yb[q][j] = y1[64 * j]; } }
#pragma unroll
            for (int q = 0; q < 2; ++q) { const int row = row0 + 2 * pr + q; float s = 0.f; f32x4 v[4];
#pragma unroll
                for (int j = 0; j < 4; ++j) { const u32x2 x = xv[q][j], a = ya[q][j], b = yb[q][j];
                    v[j].x = blo(x.x) + w0[q] * blo(a.x) + w1[q] * blo(b.x); v[j].y = bhi(x.x) + w0[q] * bhi(a.x) + w1[q] * bhi(b.x); v[j].z = blo(x.y) + w0[q] * blo(a.y) + w1[q] * blo(b.y); v[j].w = bhi(x.y) + w0[q] * bhi(a.y) + w1[q] * bhi(b.y);
                    s += (v[j].x * v[j].x + v[j].y * v[j].y) + (v[j].z * v[j].z + v[j].w * v[j].w); }
                const float rstd = rsqrtf(wave_total(s) * (1.0f / 1024.0f) + 1e-6f);
                if (!final_layer) { u32x2* o = (u32x2*)(XB + (size_t)row * 1024) + lane; u32x2* r = (u32x2*)(XR + (size_t)row * 1024) + lane;
#pragma unroll
                    for (int j = 0; j < 4; ++j) { u32x2 w; w.x = pk2(v[j].x, v[j].y); w.y = pk2(v[j].z, v[j].w); r[64 * j] = w; w.x = pk2(v[j].x * rstd, v[j].y * rstd); w.y = pk2(v[j].z * rstd, v[j].w * rstd); o[64 * j] = w; } }
                else { const f32x4* gr = (const f32x4*)gf + lane; f32x4* xw = (f32x4*)(OUT + (size_t)row * 1024) + lane;
#pragma unroll
                    for (int j = 0; j < 4; ++j) { const f32x4 g = gr[64 * j]; xw[64 * j] = v[j] * rstd * g; } } }
        }
    }
}
}
constexpr int NWAVES = 8;
constexpr int LDS_BYTES = 153600;
constexpr int MISC_OFF = 152576;
constexpr int CW_BAR = 8192;

#define XB_TMO      128
#define XB_XCNT(j)  (256  + 64 * (j))
#define XB_XSUB(j)  (1280 + 64 * (j))
#define XB_XGEN(j)  (2304 + 64 * (j))
#define XB_TOP      3328
#define XB_TOPGEN   3392
#define XCD_BAR_WORDS 3456
#define XB_SPIN_CAP (1u << 18)
__device__ __forceinline__ unsigned xb_ld(unsigned* p)              { return __hip_atomic_load(p, __ATOMIC_RELAXED, __HIP_MEMORY_SCOPE_AGENT); }
__device__ __forceinline__ unsigned xb_add(unsigned* p, unsigned v) { return __hip_atomic_fetch_add(p, v, __ATOMIC_RELAXED, __HIP_MEMORY_SCOPE_AGENT); }
__device__ __forceinline__ unsigned xb_xcc_id() { return (unsigned)__builtin_amdgcn_s_getreg((3 << 11) | 20) & 0xFu; }
#define XB_SPIN(cond, bar) do { unsigned _sp = 0; while (cond) { __builtin_amdgcn_s_sleep(1); \
    if ((++_sp & 255u) == 0u) { if (xb_ld(&(bar)[XB_TMO])) break; if (_sp > XB_SPIN_CAP) { atomicAdd(&(bar)[XB_TMO], 1u); break; } } } } while (0)
struct XcdBarrier { unsigned* bar; unsigned x; volatile LAS unsigned* st; };
__device__ __forceinline__ XcdBarrier xcd_barrier_post(unsigned* bar, volatile LAS unsigned* st) {
    XcdBarrier b; b.bar = bar; b.x = xb_xcc_id(); b.st = st;
    if (threadIdx.x == 0) (void)xb_add(&bar[XB_XCNT(b.x)], 1u);
    return b;
}
__device__ __forceinline__ void xcd_barrier_complete(unsigned* bar, unsigned x, unsigned& nloc, unsigned& nx) {
    const unsigned G = gridDim.x * gridDim.y * gridDim.z;
    unsigned sum, cnt, mine, sp = 0u;
    for (;;) {
        sum = 0u; cnt = 0u; mine = 0u;
#pragma unroll
        for (unsigned j = 0; j < 16; ++j) { const unsigned c = xb_ld(&bar[XB_XCNT(j)]); sum += c; cnt += (c > 0u) ? 1u : 0u; mine = (j == x) ? c : mine; }
        if (sum == G) break;
        __builtin_amdgcn_s_sleep(1);
        if ((++sp & 255u) == 0u) { if (xb_ld(&bar[XB_TMO])) break; if (sp > XB_SPIN_CAP) { atomicAdd(&bar[XB_TMO], 1u); break; } }
    }
    nloc = mine > 0u ? mine : 1u; nx = cnt > 0u ? cnt : 1u;
}
__device__ __forceinline__ void xcd_barrier(const XcdBarrier& b) {
    asm volatile("s_waitcnt vmcnt(0)" ::: "memory");
    __syncthreads();
    if (threadIdx.x == 0) {
        unsigned* bar = b.bar;
        __builtin_amdgcn_s_waitcnt(0);
        unsigned nloc = b.st[0], nx = b.st[1];
        if (nloc == 0u) { xcd_barrier_complete(bar, b.x, nloc, nx); b.st[0] = nloc; b.st[1] = nx; }
        const unsigned old = xb_add(&bar[XB_XSUB(b.x)], 1u);
        const unsigned gen = old / nloc;
        if (old + 1u == (gen + 1u) * nloc) {
            __builtin_amdgcn_fence(__ATOMIC_RELEASE, "agent");
            asm volatile("s_waitcnt vmcnt(0)" ::: "memory");
            const unsigned og = xb_add(&bar[XB_TOP], 1u);
            const unsigned tg = og / nx;
            if (og + 1u == (tg + 1u) * nx) xb_add(&bar[XB_TOPGEN], 1u);
            else XB_SPIN(xb_ld(&bar[XB_TOPGEN]) == tg, bar);
            __builtin_amdgcn_fence(__ATOMIC_ACQUIRE, "agent");
            xb_add(&bar[XB_XGEN(b.x)], 1u);
            asm volatile("s_waitcnt vmcnt(0)" ::: "memory");
        } else {
            XB_SPIN(xb_ld(&bar[XB_XGEN(b.x)]) == gen, bar);
            __builtin_amdgcn_fence(__ATOMIC_ACQUIRE, "agent");
            asm volatile("s_waitcnt vmcnt(0)" ::: "memory");
        }
    }
    __syncthreads();
}

struct Args { const float* in[26]; float* out; unsigned char* ws; int ph_lo, ph_hi, li, pad; };
struct ArgsG { const GAS float* in[26]; GAS float* out; GAS unsigned char* ws; int ph_lo, ph_hi, li, pad; };
static_assert(sizeof(Args) == sizeof(ArgsG), "Args layout");
constexpr int N_PHASES = 18;

__device__ __forceinline__ void build_moe_tab(const int* cnt, volatile LAS int* tp, volatile LAS int* cn, int tid) {
    if (tid < 32) cn[tid] = __hip_atomic_load(cnt + tid * CNT_STRIDE, __ATOMIC_RELAXED, __HIP_MEMORY_SCOPE_AGENT);
    __syncthreads();
    if (tid == 0) { int p = 0; for (int e = 0; e < 32; ++e) { tp[e] = p; p += (cn[e] + 255) >> 8; } tp[32] = p; }
    __syncthreads();
}

__global__ void __launch_bounds__(NWAVES * 64, 2) mega_fwd(Args a_unused) {
    typedef const ArgsG __attribute__((address_space(4)))* KArgs;
#define PIN_KA() KArgs a = (KArgs)__builtin_amdgcn_kernarg_segment_ptr(); asm volatile("" : "+s"(a))
    extern __shared__ __attribute__((aligned(16))) unsigned char lds_raw[];
    LAS unsigned char* lds = (LAS unsigned char*)lds_raw;
    volatile LAS unsigned* MISC = (volatile LAS unsigned*)(lds + MISC_OFF);
    const int tid = threadIdx.x, lane = tid & 63, wave = __builtin_amdgcn_readfirstlane(tid >> 6);
    const int G = gridDim.x, bx = blockIdx.x, vcu = (G % 8 == 0) ? (bx % 8) * (G / 8) + bx / 8 : bx;
    const int gw = vcu * NWAVES + wave, NGW = G * NWAVES;
#ifndef NCONV_CFG
#define NCONV_CFG 96
#define UCONV_CFG 4
#endif
    const int NCONV = (G == 256) ? NCONV_CFG : 0, UCONV = UCONV_CFG;
    unsigned* ctl; int lo, hi;
    { PIN_KA(); ctl = (unsigned*)((unsigned char*)a->ws + WS_CTL) + CW_BAR + a->li * XCD_BAR_WORDS; lo = a->ph_lo; hi = a->ph_hi; }
    for (int u = tid; u < 256; u += NWAVES * 64) MISC[u] = 0u;
    __syncthreads();
    XcdBarrier bar; bar.bar = ctl; bar.x = 0; bar.st = MISC + 8;
    if (hi - lo > 1) bar = xcd_barrier_post(ctl, MISC + 8);
#ifdef ONLY_PHASE
#define RUN(k) ((((k) < 2 ? (k) : 2 + ((k) - 2) % 8) == ONLY_PHASE) && lo <= (k) && (k) < hi)
#else
#define RUN(k) (lo <= (k) && (k) < hi)
#endif
#define PIN_TID() int ptid = threadIdx.x; asm volatile("" : "+v"(ptid)); const int plane = ptid & 63
#ifndef REPEAT_PHASE
#define REPEAT_PHASE (-1)
#endif
#define NREP(k) (((((k) < 2 ? (k) : 2 + ((k) - 2) % 8) == REPEAT_PHASE) ? 2 : 1))
#ifdef DOUBLE_SEAM
#define SEAM(k) do { if (RUN(k) && RUN((k) + 1)) { xcd_barrier(bar); xcd_barrier(bar); } } while (0)
#else
#define SEAM(k) do { if (RUN(k) && RUN((k) + 1)) xcd_barrier(bar); } while (0)
#endif
    volatile LAS int* tpre = (volatile LAS int*)(lds + MISC_OFF + 256); volatile LAS int* tcn = (volatile LAS int*)(lds + MISC_OFF + 512);
#define PIN_WS() PIN_KA(); GAS unsigned char* wsg = a->ws; asm volatile("" : "+s"(wsg)); unsigned char* ws = (unsigned char*)wsg
#define BUF(T, off) ((T*)(ws + (off)))

    for (int rep_ = 0; rep_ < NREP(0); ++rep_) if (RUN(0)) { PIN_WS();
        { PIN_TID(); tp::p0_prologue(a->in, ws, gw, NGW, plane, NCONV > 0); }
    }
    SEAM(0);
    for (int l = 0; l < NLAYER; ++l) {
        const int pb = 2 + 8 * l;
        if (l == 0 && NCONV > 0 && RUN(pb + 0) && bx >= G - NCONV) { PIN_WS();
            { PIN_TID(); tp::p0_items<2>(a->in, ws, (bx - (G - NCONV)) * NWAVES + wave, NCONV * NWAVES, plane); }
            __syncthreads(); }
        for (int rep_ = 0; rep_ < NREP(pb + 0); ++rep_) if (RUN(pb + 0)) { PIN_WS(); gp::PhGemm1 ph; ph.XB = BUF(const char, WS_XB); ph.WT = BUF(const char, W_IN + (size_t)l * 18 * MiB); ph.rs = BUF(float, WS_RT + RT_RS); ph.bglu = (const float*)a->in[8] + l * 2048; ph.bgate = (const float*)a->in[5] + l * 3072;
            ph.CV = BUF(bf16_t, WS_CV); ph.GB = BUF(bf16_t, WS_GB); ph.U = BUF(bf16_t, WS_U); ph.Q = BUF(bf16_t, WS_Q); ph.G = BUF(bf16_t, WS_G); ph.Gd = G; ph.c = bx; ph.only = a->pad; ph.nconv = (l == 0) ? NCONV : 0; ph.ucv = UCONV; ge::gemm_phase(lds, ph); }
        if (l == 0) { for (int rep_ = 0; rep_ < NREP(1); ++rep_) if (RUN(1)) { PIN_WS(); gp::PhKV ph; ph.MEMN = BUF(const char, WS_MEMN); ph.WT = BUF(const char, W_KV); ph.KV = BUF(bf16_t, WS_KV); ph.Gd = G; ph.c = bx; ph.nconv = NCONV; ge::gemm_phase(lds, ph); } }
        SEAM(pb + 0);
        for (int rep_ = 0; rep_ < NREP(pb + 1); ++rep_) if (RUN(pb + 1)) {
#ifndef P2REP
#define P2REP (-1)
#endif
#define P2RUN(x) (rep_ == NREP(pb + 1) - 1 || (x) == P2REP)
#if !defined(P2SEL) || P2SEL == 0
            if (P2RUN(0)) { PIN_WS(); PIN_TID(); (void)plane; tp::attn_phase(BUF(bf16_t, WS_Q), BUF(bf16_t, WS_KV) + (size_t)l * 1024 * 2048, BUF(bf16_t, WS_O), lds, vcu, G, ptid); }
            asm volatile("" ::: "memory"); __builtin_amdgcn_sched_barrier(0);
#endif
#if !defined(P2SEL) || P2SEL == 1
            if (P2RUN(1)) { PIN_WS(); PIN_TID(); (void)plane; tp::bconv_phase(BUF(bf16_t, WS_U), (const float*)a->in[9] + l * 31 * 1024, (const float*)a->in[10] + l * 1024, (const float*)a->in[11] + l * 1024, (const float*)a->in[12] + l * 1024, BUF(bf16_t, WS_UB), lds, vcu, G, ptid); }
            asm volatile("" ::: "memory"); __builtin_amdgcn_sched_barrier(0);
#endif
#if !defined(P2SEL) || P2SEL == 2
            if (P2RUN(2)) { PIN_WS(); PIN_TID(); (void)plane; tp::aconv_phase(BUF(bf16_t, WS_CV), BUF(bf16_t, WS_GB), (const float*)a->in[6] + l * 3 * 1024, BUF(bf16_t, WS_AC), vcu, G, ptid); }
#endif
        }
        SEAM(pb + 1);
        for (int rep_ = 0; rep_ < NREP(pb + 2); ++rep_) if (RUN(pb + 2)) { PIN_WS();
            static_assert(WS_UB - WS_AC == 32 * MiB && WS_O - WS_UB == 32 * MiB && W_OB - W_OA == 4 * MiB && W_OX - W_OB == 4 * MiB, "PhOut3 strides");
            gp::PhOut3 ph; ph.AC = BUF(const char, WS_AC); ph.WA = BUF(const char, W_OA + (size_t)l * 2 * MiB); ph.bb = (const float*)a->in[14] + l * 1024; ph.G = BUF(bf16_t, WS_G); ph.MG = BUF(bf16_t, WS_MG); ph.pcnt = BUF(unsigned, WS_CTL) + CW_PCNT + l * PCNT_LAYER; ph.Gd = G; ph.c = bx; ge::gemm_phase(lds, ph); }
#ifdef MIX_SEAMS
        SEAM(pb + 2);
#endif
        for (int rep_ = 0; rep_ < NREP(pb + 3); ++rep_) if (RUN(pb + 3)) { PIN_WS(); gp::PhWo ph; ph.MG = BUF(const char, WS_MG); ph.WT = BUF(const char, W_O + (size_t)l * 2 * MiB); ph.xin_f = (l == 0) ? (const float*)a->in[0] : nullptr; ph.xin_b = BUF(bf16_t, WS_XR); ph.XBo = BUF(bf16_t, WS_XB); ph.pin = BUF(unsigned, WS_CTL) + CW_PCNT + l * PCNT_LAYER; ph.pout = ph.pin + 4096; ph.tmo = BUF(unsigned, WS_CTL) + CW_TMO; ph.Gd = G; ph.c = bx; ge::gemm_phase(lds, ph); }
#ifdef MIX_SEAMS
        SEAM(pb + 3);
#endif
        for (int rep_ = 0; rep_ < NREP(pb + 4); ++rep_) if (RUN(pb + 4)) { PIN_WS(); tp::RouteArgs r; r.pcnt = BUF(unsigned, WS_CTL) + CW_PCNT + l * PCNT_LAYER + 4096; r.tmo = BUF(unsigned, WS_CTL) + CW_TMO; r.X = BUF(bf16_t, WS_XB); r.WR = BUF(bf16_t, W_RT) + (size_t)l * 98304; r.bg = (const float*)a->in[20] + l * 4; r.br = (const float*)a->in[22] + l * 32; r.RS = BUF(float, WS_RT + RT_RS);
            r.tok_e = BUF(int, WS_RT + RT_TOKE); r.tok_pos = BUF(int, WS_RT + RT_TOKP); r.tok_w = BUF(float, WS_RT + RT_TOKW);
            r.cnt = BUF(int, WS_CTL) + CW_CNT + l * CNT_LAYER; r.list = BUF(int, WS_RT + RT_LIST); r.rsl = BUF(float, WS_RSL);
            if (NREP(pb + 4) == 2 && rep_ == 0) { r.RS = BUF(float, WS_F32A); r.tok_e = BUF(int, WS_F32A + 1 * MiB); r.tok_pos = BUF(int, WS_F32A + 2 * MiB); r.tok_w = BUF(float, WS_F32A + 3 * MiB); r.cnt = BUF(int, WS_CTL) + CW_CNT + 2 * CNT_LAYER + l * CNT_LAYER; r.list = BUF(int, WS_F32A + 4 * MiB); r.rsl = BUF(float, WS_F32A + 8 * MiB); } { PIN_TID(); (void)plane; tp::route_phase(r, lds, vcu, G, ptid); } }
        SEAM(pb + 4);
        for (int rep_ = 0; rep_ < NREP(pb + 5); ++rep_) if (RUN(pb + 5)) { PIN_WS(); build_moe_tab(BUF(int, WS_CTL) + CW_CNT + l * CNT_LAYER, tpre, tcn, tid);
            gp::PhMoeGU ph; ph.XB = BUF(const char, WS_XB); ph.WT = BUF(const char, W_GU + (size_t)l * 64 * MiB); ph.list = BUF(int, WS_RT + RT_LIST); ph.rsl = BUF(float, WS_RSL); ph.HID = BUF(bf16_t, WS_HID);
            ph.tcnt = BUF(unsigned, WS_CTL) + CW_TCNT + l * TCNT_LAYER; ph.tb.tp = (const LAS int*)tpre; ph.tb.cn = (const LAS int*)tcn; ph.Gd = G; ph.c = vcu; ge::gemm_phase(lds, ph); }
#ifdef MOE_SEAM
        SEAM(pb + 5);
#endif
        for (int rep_ = 0; rep_ < NREP(pb + 6); ++rep_) if (RUN(pb + 6)) { PIN_WS(); build_moe_tab(BUF(int, WS_CTL) + CW_CNT + l * CNT_LAYER, tpre, tcn, tid);
            gp::PhMoeDn ph; ph.HID = BUF(const char, WS_HID); ph.WT = BUF(const char, W_DN + (size_t)l * 32 * MiB); ph.Y = BUF(bf16_t, WS_Y); ph.tcnt = BUF(unsigned, WS_CTL) + CW_TCNT + l * TCNT_LAYER; ph.tmo = BUF(unsigned, WS_CTL) + CW_TMO; ph.tb.tp = (const LAS int*)tpre; ph.tb.cn = (const LAS int*)tcn; ph.Gd = G; ph.c = vcu;
            ge::gemm_phase(lds, ph); }
        SEAM(pb + 6);
        for (int rep_ = 0; rep_ < NREP(pb + 7); ++rep_) if (RUN(pb + 7)) { PIN_WS(); build_moe_tab(BUF(int, WS_CTL) + CW_CNT + l * CNT_LAYER, tpre, tcn, tid);
            { PIN_TID(); tp::combine_phase(BUF(bf16_t, WS_XB), BUF(bf16_t, WS_XR), (float*)a->out, BUF(bf16_t, WS_Y), BUF(int, WS_RT + RT_TOKE), BUF(int, WS_RT + RT_TOKP), BUF(float, WS_RT + RT_TOKW), (const LAS int*)tpre, (const float*)a->in[25], l == NLAYER - 1, gw, NGW, plane); } }
        SEAM(pb + 7);
    }
#undef RUN
#undef SEAM
}

static int g_grid = 0;
static bool mega_setup() {
    if (g_grid) return g_grid > 0;
    int dev = 0, cus = 0;
    if (hipGetDevice(&dev) != hipSuccess || hipDeviceGetAttribute(&cus, hipDeviceAttributeMultiprocessorCount, dev) != hipSuccess) { g_grid = -1; return false; }
    if (hipFuncSetAttribute((const void*)mega_fwd, hipFuncAttributeMaxDynamicSharedMemorySize, LDS_BYTES) != hipSuccess) { fprintf(stderr, "mega: hipFuncSetAttribute failed\n"); g_grid = -1; return false; }
    int per_cu = 0;
    if (hipOccupancyMaxActiveBlocksPerMultiprocessor(&per_cu, (const void*)mega_fwd, NWAVES * 64, LDS_BYTES) != hipSuccess || per_cu < 1) { fprintf(stderr, "mega: occupancy query says %d blocks/CU\n", per_cu); (void)hipGetLastError(); }
    g_grid = cus;
    return true;
}
static void mega_launch(void* const* d_in, void* d_out, void* d_ws, int lo, int hi, int li, hipStream_t stream, int only = 0) {
    if (!mega_setup()) return;
    Args a{};
    for (int i = 0; i < 26; ++i) a.in[i] = (const float*)d_in[i];
    a.out = (float*)d_out; a.ws = (unsigned char*)d_ws; a.ph_lo = lo; a.ph_hi = hi; a.li = li; a.pad = only;
    hipLaunchKernelGGL(mega_fwd, dim3(g_grid), dim3(NWAVES * 64), LDS_BYTES, stream, a);
}
extern "C" void kernel_launch(void* const* d_in, const int* in_sizes, int n_in, void* d_out, int out_size, void* d_ws, size_t ws_size, hipStream_t stream) {
    if (n_in != 26 || out_size != T_ROWS * DM || ws_size < WS_END) { fprintf(stderr, "kernel_launch: unexpected shapes/ws (%d inputs, out %d, ws %zu)\n", n_in, out_size, ws_size); return; }
    (void)hipMemsetAsync((char*)d_ws + WS_CTL, 0, CTL_BYTES, stream);
    mega_launch(d_in, d_out, d_ws, 0, N_PHASES, 0, stream);
}
```
